# Optimizing an MI355X kernel written in HIP

```python
import jax
import jax.numpy as jnp
from jax import lax
import numpy as np

D_MODEL = 2048
BATCH = 8
SEQ = 4096
DEPTH = 4

HEAD_DIM = 128
BRANCH_WIDTH = D_MODEL // 2
N_BRANCH = 3
PLE_DIM = 256
NORM_EPS = 1e-6

LRU_BLOCK = 64
LRU_BLOCKS = BRANCH_WIDTH // LRU_BLOCK
CONV_WIDTH = 4
LRU_C = 8.0

NSA_HEADS = BRANCH_WIDTH // HEAD_DIM
NSA_KV_HEADS = 2
NSA_GROUP = NSA_HEADS // NSA_KV_HEADS
NSA_KV_WIDTH = NSA_KV_HEADS * HEAD_DIM
CMP_BLOCK = 32
CMP_STRIDE = 16
CMP_HIDDEN = 256
SEL_BLOCK = 64
SEL_TOPK = 16
WINDOW = 512
NSA_Q_BLOCK = 32

FOX_HEADS = BRANCH_WIDTH // HEAD_DIM
FOX_Q_BLOCK = 128
FORGET_BIAS = 3.0

IN_SPLITS = (
    ('lru_x', BRANCH_WIDTH), ('lru_gate', BRANCH_WIDTH),
    ('nsa_q', BRANCH_WIDTH),
    ('nsa_k_cmp', NSA_KV_WIDTH), ('nsa_v_cmp', NSA_KV_WIDTH),
    ('nsa_k_slc', NSA_KV_WIDTH), ('nsa_v_slc', NSA_KV_WIDTH),
    ('nsa_k_win', NSA_KV_WIDTH), ('nsa_v_win', NSA_KV_WIDTH),
    ('nsa_bgate', NSA_HEADS * 3), ('nsa_gate', BRANCH_WIDTH),
    ('fox_q', BRANCH_WIDTH), ('fox_k', BRANCH_WIDTH), ('fox_v', BRANCH_WIDTH),
    ('fox_f', FOX_HEADS), ('fox_gate', BRANCH_WIDTH),
    ('merge', N_BRANCH * D_MODEL),
)
N_IN = sum(size for _, size in IN_SPLITS)

kernel_name = 'hybrid_rglru_nsa_fox_block'


def column_offsets():
    offs, start = {}, 0
    for name, size in IN_SPLITS:
        offs[name] = (start, size)
        start += size
    return offs


def split_columns(z):
    return {name: z[..., s:s + n] for name, (s, n) in column_offsets().items()}


def split_heads(t, n_heads):
    b, s, _ = t.shape
    return t.reshape(b, s, n_heads, HEAD_DIM)


def rms_norm(x, gain):
    xf = x.astype(jnp.float32)
    y = xf * lax.rsqrt(jnp.mean(xf * xf, axis=-1, keepdims=True) + NORM_EPS)
    return (y * gain.astype(jnp.float32)).astype(x.dtype)


def masked_softmax(logits, mask):
    logits = jnp.where(mask, logits.astype(jnp.float32), -jnp.inf)
    m = jnp.max(logits, axis=-1, keepdims=True)
    m = jnp.where(jnp.isfinite(m), m, 0.0)
    e = jnp.exp(logits - m)
    return e / jnp.maximum(jnp.sum(e, axis=-1, keepdims=True), 1e-30)


def linear_combine(left, right):
    a_l, b_l = left
    a_r, b_r = right
    return a_l * a_r, a_r * b_l + b_r


def rglru_branch(u, conv_w, conv_b, wa, ba, wx, bx, lam):
    b, s, w = u.shape
    taps = conv_w[:, None, :].astype(u.dtype)
    uc = lax.conv_general_dilated(u, taps, (1,), ((CONV_WIDTH - 1, 0),),
                                  dimension_numbers=('NWC', 'WIO', 'NWC'),
                                  feature_group_count=w) + conv_b
    ub = uc.reshape(b, s, LRU_BLOCKS, LRU_BLOCK)
    rec = jax.nn.sigmoid((jnp.einsum('bsnk,nkj->bsnj', ub, wa).reshape(b, s, w) + ba).astype(jnp.float32))
    inp = jax.nn.sigmoid((jnp.einsum('bsnk,nkj->bsnj', ub, wx).reshape(b, s, w) + bx).astype(jnp.float32))
    log_a = -LRU_C * rec * jax.nn.softplus(-lam.astype(jnp.float32))
    a = jnp.exp(log_a)
    drive = jnp.sqrt(-jnp.expm1(2.0 * log_a)) * (inp * uc.astype(jnp.float32))
    _, hseq = lax.associative_scan(linear_combine, (a, drive), axis=1)
    return hseq.astype(u.dtype)


def compress(t, pos, w1, w2):
    b, s, hk, dk = t.shape
    n_chunk = s // CMP_STRIDE
    ratio = CMP_BLOCK // CMP_STRIDE
    n_cmp = n_chunk - ratio + 1
    chunks = t.reshape(b, n_chunk, CMP_STRIDE, hk, dk)
    blocks = jnp.concatenate([chunks[:, r:r + n_cmp] for r in range(ratio)], axis=2)
    blocks = blocks + pos[:, None, :]
    flat = blocks.transpose(0, 1, 3, 2, 4).reshape(b, n_cmp, hk, CMP_BLOCK * dk)
    return jax.nn.silu(flat @ w1) @ w2


def nsa_branch(q, kc, vc, ks, vs, kw, vw, gates):
    b, s, h, dk = q.shape
    scale = dk ** -0.5
    n_cmp = kc.shape[1]
    n_sel = s // SEL_BLOCK
    n_top = min(SEL_TOPK, n_sel)
    nb = s // NSA_Q_BLOCK
    cmp_start = jnp.arange(n_cmp) * CMP_STRIDE
    cmp_end = cmp_start + CMP_BLOCK - 1
    sel_ids = jnp.arange(n_sel)
    sel_start = sel_ids * SEL_BLOCK
    overlap = ((cmp_start[:, None] < sel_start[None, :] + SEL_BLOCK)
               & (cmp_start[:, None] + CMP_BLOCK > sel_start[None, :])).astype(jnp.float32)
    ks_blk = ks.reshape(b, n_sel, SEL_BLOCK, NSA_KV_HEADS, dk).transpose(0, 3, 1, 2, 4)
    vs_blk = vs.reshape(b, n_sel, SEL_BLOCK, NSA_KV_HEADS, dk).transpose(0, 3, 1, 2, 4)
    bi = jnp.arange(b)[:, None, None, None]
    gi = jnp.arange(NSA_KV_HEADS)[None, None, :, None]
    pad = ((0, 0), (WINDOW, 0), (0, 0), (0, 0))
    kw_pad = jnp.pad(kw, pad)
    vw_pad = jnp.pad(vw, pad)
    win_off = jnp.arange(WINDOW + NSA_Q_BLOCK) - WINDOW
    q_blocks = q.reshape(b, nb, NSA_Q_BLOCK, NSA_KV_HEADS, NSA_GROUP, dk).swapaxes(0, 1)
    g_blocks = gates.reshape(b, nb, NSA_Q_BLOCK, NSA_KV_HEADS, NSA_GROUP, 3).swapaxes(0, 1)
    t0s = jnp.arange(nb, dtype=jnp.int32) * NSA_Q_BLOCK
    flat_sel = n_top * SEL_BLOCK

    def block(args):
        qb, gb, t0 = args
        tq = t0 + jnp.arange(NSA_Q_BLOCK)
        s_c = jnp.einsum('btgqd,bcgd->btgqc', qb, kc) * scale
        m_c = (cmp_end[None, :] <= tq[:, None])[None, :, None, None, :]
        p_c = masked_softmax(s_c, m_c)
        o_c = jnp.einsum('btgqc,bcgd->btgqd', p_c.astype(vc.dtype), vc)
        imp = jnp.einsum('btgqc,cj->btgj', p_c, overlap)
        cur = (tq // SEL_BLOCK)[:, None]
        valid = sel_ids[None, :] <= cur
        forced = (sel_ids[None, :] == 0) | (sel_ids[None, :] == cur) | (sel_ids[None, :] == cur - 1)
        score = jnp.where(forced[None, :, None, :], jnp.inf,
                          jnp.where(valid[None, :, None, :], imp, -jnp.inf))
        _, idx = lax.top_k(score, n_top)
        k_sel = ks_blk[bi, gi, idx]
        v_sel = vs_blk[bi, gi, idx]
        s_s = jnp.einsum('btgqd,btgnkd->btgqnk', qb, k_sel) * scale
        kpos = idx[..., None] * SEL_BLOCK + jnp.arange(SEL_BLOCK)
        m_s = kpos <= tq[None, :, None, None, None]
        p_s = masked_softmax(s_s.reshape(b, NSA_Q_BLOCK, NSA_KV_HEADS, NSA_GROUP, flat_sel),
                             m_s.reshape(b, NSA_Q_BLOCK, NSA_KV_HEADS, 1, flat_sel))
        o_s = jnp.einsum('btgqm,btgmd->btgqd', p_s.astype(vs.dtype),
                         v_sel.reshape(b, NSA_Q_BLOCK, NSA_KV_HEADS, flat_sel, dk))
        k_w = lax.dynamic_slice_in_dim(kw_pad, t0, WINDOW + NSA_Q_BLOCK, axis=1)
        v_w = lax.dynamic_slice_in_dim(vw_pad, t0, WINDOW + NSA_Q_BLOCK, axis=1)
        wpos = t0 + win_off
        m_w = ((wpos[None, :] >= 0) & (wpos[None, :] <= tq[:, None])
               & (wpos[None, :] > tq[:, None] - WINDOW))[None, :, None, None, :]
        s_w = jnp.einsum('btgqd,bkgd->btgqk', qb, k_w) * scale
        p_w = masked_softmax(s_w, m_w)
        o_w = jnp.einsum('btgqk,bkgd->btgqd', p_w.astype(vw.dtype), v_w)
        return gb[..., 0:1] * o_c + gb[..., 1:2] * o_s + gb[..., 2:3] * o_w

    out = lax.map(block, (q_blocks, g_blocks, t0s))
    return out.swapaxes(0, 1).reshape(b, s, h * dk)


def fox_branch(q, k, v, log_f):
    b, s, h, dk = q.shape
    scale = dk ** -0.5
    nb = s // FOX_Q_BLOCK
    c = jnp.cumsum(log_f, axis=1)
    ck = c.transpose(0, 2, 1)
    kpos = jnp.arange(s)
    q_blocks = q.reshape(b, nb, FOX_Q_BLOCK, h, dk).swapaxes(0, 1)
    c_blocks = c.reshape(b, nb, FOX_Q_BLOCK, h).swapaxes(0, 1)
    t0s = jnp.arange(nb, dtype=jnp.int32) * FOX_Q_BLOCK

    def block(args):
        qb, cb, t0 = args
        tq = t0 + jnp.arange(FOX_Q_BLOCK)
        logits = jnp.einsum('bqhd,bkhd->bhqk', qb, k).astype(jnp.float32) * scale
        logits = logits + (cb.transpose(0, 2, 1)[..., None] - ck[:, :, None, :])
        p_att = masked_softmax(logits, kpos[None, :] <= tq[:, None])
        return jnp.einsum('bhqk,bkhd->bqhd', p_att.astype(v.dtype), v)

    out = lax.map(block, (q_blocks, c_blocks, t0s))
    return out.swapaxes(0, 1).reshape(b, s, h * dk)


def setup_inputs(seed: int = 0) -> dict:
    key = jax.random.key(seed)
    ks = jax.random.split(key, 26)
    f32 = jnp.float32

    def nrm(k, shape, fan_in):
        return jax.random.normal(k, shape, f32) * (fan_in ** -0.5)

    def gain(k, shape):
        return 1.0 + 0.05 * jax.random.normal(k, shape, f32)

    def small(k, shape):
        return 0.02 * jax.random.normal(k, shape, f32)

    x = jax.random.normal(ks[0], (BATCH, SEQ, D_MODEL), f32)
    p = jax.random.normal(ks[1], (DEPTH, BATCH, SEQ, PLE_DIM), f32)
    ln_gain = gain(ks[2], (DEPTH, D_MODEL))
    w_in = nrm(ks[3], (DEPTH, D_MODEL, N_IN), D_MODEL)
    f_off = column_offsets()['fox_f'][0]
    b_in = small(ks[4], (DEPTH, N_IN)).at[:, f_off:f_off + FOX_HEADS].add(FORGET_BIAS)
    conv_w = nrm(ks[5], (DEPTH, CONV_WIDTH, BRANCH_WIDTH), CONV_WIDTH)
    conv_b = small(ks[6], (DEPTH, BRANCH_WIDTH))
    lru_wa = nrm(ks[7], (DEPTH, LRU_BLOCKS, LRU_BLOCK, LRU_BLOCK), LRU_BLOCK)
    lru_ba = small(ks[8], (DEPTH, BRANCH_WIDTH))
    lru_wx = nrm(ks[9], (DEPTH, LRU_BLOCKS, LRU_BLOCK, LRU_BLOCK), LRU_BLOCK)
    lru_bx = small(ks[10], (DEPTH, BRANCH_WIDTH))
    a0 = jax.random.uniform(ks[11], (DEPTH, BRANCH_WIDTH), f32, minval=0.9, maxval=0.999)
    root = a0 ** (1.0 / LRU_C)
    lru_lambda = jnp.log(root) - jnp.log1p(-root)
    cmp_w1 = nrm(ks[12], (DEPTH, 2, CMP_BLOCK * HEAD_DIM, CMP_HIDDEN), CMP_BLOCK * HEAD_DIM)
    cmp_w2 = nrm(ks[13], (DEPTH, 2, CMP_HIDDEN, HEAD_DIM), CMP_HIDDEN)
    cmp_pos = small(ks[14], (DEPTH, 2, CMP_BLOCK, HEAD_DIM))
    nsa_q_gain = gain(ks[15], (DEPTH, HEAD_DIM))
    nsa_k_gain = gain(ks[16], (DEPTH, HEAD_DIM))
    fox_q_gain = gain(ks[17], (DEPTH, HEAD_DIM))
    fox_k_gain = gain(ks[18], (DEPTH, HEAD_DIM))
    w_branch = nrm(ks[19], (DEPTH, N_BRANCH, BRANCH_WIDTH, D_MODEL), BRANCH_WIDTH)
    w_out = nrm(ks[20], (DEPTH, D_MODEL, D_MODEL), D_MODEL)
    w_ple = nrm(ks[21], (DEPTH, PLE_DIM, D_MODEL), PLE_DIM)
    ple_gain = gain(ks[22], (DEPTH, D_MODEL))
    w_ple_gate = nrm(ks[23], (DEPTH, D_MODEL, D_MODEL), D_MODEL)
    return {'x': x, 'p': p, 'ln_gain': ln_gain, 'w_in': w_in, 'b_in': b_in,
            'conv_w': conv_w, 'conv_b': conv_b, 'lru_wa': lru_wa, 'lru_ba': lru_ba,
            'lru_wx': lru_wx, 'lru_bx': lru_bx, 'lru_lambda': lru_lambda,
            'cmp_w1': cmp_w1, 'cmp_w2': cmp_w2, 'cmp_pos': cmp_pos,
            'nsa_q_gain': nsa_q_gain, 'nsa_k_gain': nsa_k_gain,
            'fox_q_gain': fox_q_gain, 'fox_k_gain': fox_k_gain,
            'w_branch': w_branch, 'w_out': w_out, 'w_ple': w_ple,
            'ple_gain': ple_gain, 'w_ple_gate': w_ple_gate}


def reference(x, p, ln_gain, w_in, b_in, conv_w, conv_b, lru_wa, lru_ba, lru_wx, lru_bx,
              lru_lambda, cmp_w1, cmp_w2, cmp_pos, nsa_q_gain, nsa_k_gain, fox_q_gain,
              fox_k_gain, w_branch, w_out, w_ple, ple_gain, w_ple_gate):
    b, s, _ = x.shape
    h = x
    for l in range(DEPTH):
        hn = rms_norm(h, ln_gain[l])
        z = split_columns(hn @ w_in[l] + b_in[l])
        y_a = rglru_branch(z['lru_x'], conv_w[l], conv_b[l], lru_wa[l], lru_ba[l],
                           lru_wx[l], lru_bx[l], lru_lambda[l]) * jax.nn.silu(z['lru_gate'])
        q_b = rms_norm(split_heads(z['nsa_q'], NSA_HEADS), nsa_q_gain[l])
        k_c = rms_norm(compress(split_heads(z['nsa_k_cmp'], NSA_KV_HEADS), cmp_pos[l, 0],
                                cmp_w1[l, 0], cmp_w2[l, 0]), nsa_k_gain[l])
        v_c = compress(split_heads(z['nsa_v_cmp'], NSA_KV_HEADS), cmp_pos[l, 1],
                       cmp_w1[l, 1], cmp_w2[l, 1])
        k_s = rms_norm(split_heads(z['nsa_k_slc'], NSA_KV_HEADS), nsa_k_gain[l])
        v_s = split_heads(z['nsa_v_slc'], NSA_KV_HEADS)
        k_w = rms_norm(split_heads(z['nsa_k_win'], NSA_KV_HEADS), nsa_k_gain[l])
        v_w = split_heads(z['nsa_v_win'], NSA_KV_HEADS)
        g_b = jax.nn.sigmoid(z['nsa_bgate']).reshape(b, s, NSA_HEADS, 3)
        y_b = nsa_branch(q_b, k_c, v_c, k_s, v_s, k_w, v_w, g_b) * jax.nn.silu(z['nsa_gate'])
        log_f = jax.nn.log_sigmoid(z['fox_f'].astype(jnp.float32))
        y_c = fox_branch(rms_norm(split_heads(z['fox_q'], FOX_HEADS), fox_q_gain[l]),
                         rms_norm(split_heads(z['fox_k'], FOX_HEADS), fox_k_gain[l]),
                         split_heads(z['fox_v'], FOX_HEADS), log_f) * jax.nn.silu(z['fox_gate'])
        mg = jax.nn.sigmoid(z['merge']).reshape(b, s, N_BRANCH, D_MODEL)
        merged = (mg[:, :, 0] * (y_a @ w_branch[l, 0])
                  + mg[:, :, 1] * (y_b @ w_branch[l, 1])
                  + mg[:, :, 2] * (y_c @ w_branch[l, 2]))
        h = h + merged @ w_out[l]
        e = rms_norm(p[l] @ w_ple[l], ple_gain[l])
        h = h + jax.nn.sigmoid(h @ w_ple_gate[l]) * e
    return h
```

```cpp
#include <hip/hip_runtime.h>
#include <cstdio>
#include <cstdint>

#ifndef SKIPMASK
#define SKIPMASK 0
#endif
#ifndef REPMASK
#define REPMASK 0
#endif
#ifndef P0_FUSEQ
#define P0_FUSEQ 1
#endif
#ifndef I8_P7
#define I8_P7 1
#endif
#ifndef I8_P6
#define I8_P6 1
#endif
#ifndef INPROJ_SP2
#define INPROJ_SP2 true
#endif
#ifndef MK_PER_PHASE
#define MK_PER_PHASE 0
#endif

#define GAS __attribute__((address_space(1)))
#define LAS __attribute__((address_space(3)))
typedef unsigned short bf16;
typedef short bf16x8 __attribute__((ext_vector_type(8)));
typedef float f32x4 __attribute__((ext_vector_type(4)));
typedef float f32x2 __attribute__((ext_vector_type(2)));
typedef unsigned u32x4 __attribute__((ext_vector_type(4)));
typedef unsigned u32x2 __attribute__((ext_vector_type(2)));

constexpr int DM = 2048, NBATCH = 8, SEQ = 4096, DEPTH = 4, T = NBATCH * SEQ, HD = 128, BW = 1024, PLE = 256;
constexpr int NIN = 15904, NINP = 16128;
constexpr int NCMP = 255, CMPH = 256;
constexpr int MRG0 = 38 * 256;
constexpr float EPS = 1e-6f;
constexpr float SCALE = 0.08838834764831845f;
constexpr int NWAVES = 8, NTHREADS = 512;

__host__ __device__ __forceinline__ int nmap(int n) {
    if (n < 4608) return n;
    if (n < 4632) return 15872 + (n - 4608);
    if (n < 8728) return n - 24;
    if (n < 8736) return 15896 + (n - 8728);
    return n - 32;
}

constexpr size_t MiB = 1u << 20;
constexpr size_t WS_CTL = 0, CTL_ZERO_BYTES = 1 * MiB;
constexpr size_t WL_IN = 0, WL_BR = 63 * MiB, WL_OUT = 75 * MiB, WL_GATE = 83 * MiB, WL_PLE = 91 * MiB, WL_C1 = 92 * MiB, WL_MISC = 96 * MiB, WL_STRIDE = 97 * MiB;
constexpr size_t WM_BIAS = 0, WM_POSB = 128 * 1024, WM_POSP = 256 * 1024, WM_GW = 512 * 1024, WM_W2T = 768 * 1024, WM_SW = 384 * 1024, WM_SG = 448 * 1024, WM_SO = 456 * 1024;
constexpr size_t WS_W = 1 * MiB;
constexpr size_t WS_Z = WS_W + DEPTH * WL_STRIDE;
constexpr size_t Z_U = 0, Z_GA = 64 * MiB, Z_GB = 128 * MiB, Z_GC = 192 * MiB, Z_QN = 256 * MiB, Z_QF = 320 * MiB, Z_KF = 384 * MiB, Z_VF = 448 * MiB;
constexpr size_t Z_KC = 512 * MiB, Z_VC = 528 * MiB, Z_KS = 544 * MiB, Z_VS = 560 * MiB, Z_KW = 576 * MiB, Z_VW = 592 * MiB, Z_MG = 608 * MiB;
constexpr size_t Z_BG = 992 * MiB, Z_LF = 995 * MiB, Z_CF = 996 * MiB, Z_END = 997 * MiB;
constexpr size_t WS_X0 = WS_Z + Z_END;
constexpr size_t WS_X1 = WS_X0 + 128 * MiB;
constexpr size_t WS_X2 = WS_X1 + 128 * MiB;
constexpr size_t WS_PB = WS_X2 + 128 * MiB;
constexpr size_t WS_HID = WS_PB + 64 * MiB;
constexpr size_t WS_KCMP = WS_HID + 4 * MiB, WS_VCMP = WS_KCMP + 1 * MiB;
constexpr size_t WS_RSE = WS_VCMP + 1 * MiB;
constexpr size_t WS_LRUS = WS_RSE + 1 * MiB;
constexpr size_t WS_PS = WS_LRUS + 4 * MiB;
constexpr size_t WS_PSE = WS_PS + 1 * MiB;
constexpr size_t WS_A8 = WS_PSE + 1 * MiB;
constexpr size_t WS_END = WS_A8 + 64 * MiB;
constexpr int CW_BAR = 4096;

constexpr int RING_BYTES = 131072;
constexpr int RED_OFF = RING_BYTES, SCR_BYTES = 16384;
constexpr int MISC_OFF = RED_OFF + SCR_BYTES;
constexpr int LDS_BYTES = MISC_OFF + 4096;

__device__ __forceinline__ float bf_lo(unsigned w) { return __uint_as_float(w << 16); }
__device__ __forceinline__ float bf_hi(unsigned w) { return __uint_as_float(w & 0xffff0000u); }
__device__ __forceinline__ float bf2f(bf16 h) { return __uint_as_float(((unsigned)h) << 16); }
__device__ __forceinline__ unsigned f2bf(float f) { unsigned u = __float_as_uint(f); return (u + 0x7fffu + ((u >> 16) & 1u)) >> 16; }
__device__ __forceinline__ unsigned pk2(float lo, float hi) { return f2bf(lo) | (f2bf(hi) << 16); }
__device__ __forceinline__ unsigned pk4_i8(float a, float b, float c, float d) { return ((unsigned)(int)a & 0xffu) | (((unsigned)(int)b & 0xffu) << 8) | (((unsigned)(int)c & 0xffu) << 16) | (((unsigned)(int)d & 0xffu) << 24); }
__device__ __forceinline__ unsigned cvt_pk_bf16(float lo, float hi) { unsigned r; asm volatile("v_cvt_pk_bf16_f32 %0, %1, %2" : "=v"(r) : "v"(lo), "v"(hi)); return r; }
__device__ __forceinline__ float sigmoidf_(float x) { return __builtin_amdgcn_rcpf(1.0f + __builtin_amdgcn_exp2f(-1.4426950408889634f * x)); }
template <int M> __device__ __forceinline__ int xlane_i(int v) { static_assert(M >= 1 && M < 32, "swizzle: xor mask within a 32-lane half"); return __builtin_amdgcn_ds_swizzle(v, (M << 10) | 0x1f); }
template <int M> __device__ __forceinline__ float xlane(float v) { return __int_as_float(xlane_i<M>(__float_as_int(v))); }
__device__ __forceinline__ float xsum32(float v) { auto rr = __builtin_amdgcn_permlane32_swap(__float_as_uint(v), __float_as_uint(v), false, false); return __uint_as_float(rr[0]) + __uint_as_float(rr[1]); }
__device__ __forceinline__ float wave_sum(float v) {
    v += xlane<1>(v); v += xlane<2>(v); v += xlane<4>(v); v += xlane<8>(v); v += xlane<16>(v); return xsum32(v);
}
__device__ __forceinline__ int lane_id() { int l; asm volatile("v_mbcnt_lo_u32_b32 %0, -1, 0\n\tv_mbcnt_hi_u32_b32 %0, -1, %0" : "=v"(l)); return l; }
__device__ __forceinline__ float clamp8(float x) { return fminf(fmaxf(x, -448.f), 448.f); }
__device__ __forceinline__ unsigned pk4_fp8(float a, float b, float c, float d) { int w = __builtin_amdgcn_cvt_pk_fp8_f32(clamp8(a), clamp8(b), 0, false); w = __builtin_amdgcn_cvt_pk_fp8_f32(clamp8(c), clamp8(d), w, true); return (unsigned)w; }
#define LDS_WAIT() asm volatile("s_waitcnt lgkmcnt(0)" ::: "memory")
#define VM_WAIT() asm volatile("s_waitcnt vmcnt(0)" ::: "memory")

namespace pg8 {
constexpr int BM = 256, BK = 64, HALF = 128, HTB = HALF * BK * 2, STAGE_BYTES = 8 * HTB, NXCD = 8, WGM = 4;
__host__ __device__ __forceinline__ int lds_byte(int r, int c) { const int st = (r >> 4) * 2 + (c >> 5), rr = r & 15, cc = c & 31, ob = rr * 64 + cc * 2; return st * 1024 + (ob ^ (((ob >> 9) & 1) << 5)); }
__host__ __device__ __forceinline__ void stage_rc(int b, int& R, int& C) { const int st = b / 1024, sb = b % 1024, swz = sb ^ (((sb >> 9) & 1) << 5); R = (st >> 1) * 16 + swz / 64; C = (st & 1) * 32 + (swz % 64) / 2; }
__host__ __device__ __forceinline__ int perm32(int rho) { const int n = rho >> 4, i = rho & 15; return 8 * (i >> 2) + 4 * n + (i & 3); }

struct Unit { int pm, pn, seg; };
struct Gemm { const bf16* A0; const bf16* A1; const bf16* A2; const bf16* B0; const bf16* B1; const bf16* B2; };

template <int M_, int N_, int NSEG = 1> struct StaticOrder {
    static constexpr int nM = M_ / BM, nN = N_ / BM, nwg = nM * nN;
    int G, c;
    __device__ void init(int G_, int c_) { G = G_; c = c_; }
    __device__ bool next(int i, Unit& u) const {
        const int it = i / NSEG; u.seg = i - it * NSEG;
        const long L = (long)it * G + c; if (L >= nwg) return false;
        int wgid = (int)L; { const int q = nwg / NXCD, r = nwg % NXCD, xcd = wgid % NXCD, off = wgid / NXCD; wgid = (xcd < r ? xcd * (q + 1) : r * (q + 1) + (xcd - r) * q) + off; }
        const int nig = WGM * nN, gid = wgid / nig, fm = gid * WGM, gsz = (nM - fm) < WGM ? (nM - fm) : WGM;
        u.pm = fm + ((wgid % nig) % gsz); u.pn = (wgid % nig) / gsz; return true;
    }
};
struct OneEach {
    int nM, n, c;
    __device__ bool next(int i, Unit& u) const { if (i > 0 || c >= n) return false; u.pm = c % nM; u.pn = 0; u.seg = c / nM; return true; }
};

typedef f32x4 Acc[2][2][4][2];
__device__ __forceinline__ void zero_acc(Acc& acc) {
#pragma unroll
    for (int a = 0; a < 2; ++a)
#pragma unroll
        for (int b = 0; b < 2; ++b)
#pragma unroll
            for (int m = 0; m < 4; ++m)
#pragma unroll
                for (int n = 0; n < 2; ++n) acc[a][b][m][n] = (f32x4){0.f, 0.f, 0.f, 0.f};
}

template <int LDA, int LDB, int K, int NSEG, int MODE = 0, class Epi, class Sched>
__device__ __forceinline__ void gemm_phase(LAS unsigned char* lds, const Gemm g, const Sched& S, const Epi& E, int wid) {
    constexpr bool FP8 = MODE == 1, I8 = MODE == 2;
    const int lane = lane_id(), tid = wid * 64 + lane;
    const int wr = wid >> 2, wc = wid & 3, fr = lane & 15, fq = lane >> 4;
    constexpr int nt = K / BK;
    unsigned voffA[2], voffB[2];
#pragma unroll
    for (int i = 0; i < 2; ++i) { int R, C; stage_rc(tid * 16 + i * 8192, R, C); const int Rb = (R & ~31) + perm32(R & 31);
        if (FP8) C = 8 * (2 * ((C & 31) >> 3) + (C >> 5));
        voffA[i] = (unsigned)(R * LDA + C) * 2u; voffB[i] = (unsigned)(Rb * LDB + C) * 2u; }
    constexpr size_t kstep = (size_t)(BK * 2);
    constexpr size_t hstepA = (size_t)HALF * LDA * 2, hstepB = (size_t)HALF * LDB * 2;
    constexpr size_t tstepA = 2 * hstepA, tstepB = 2 * hstepB;
    const unsigned ldsw = (unsigned)wid * 1024u;
    const int aoff = lds_byte(wr * 64 + fr, fq * 8), boff = lds_byte(wc * 32 + fr, fq * 8);
#define PG8_SA(b, h) (((b) * 2 + (h)) * HTB)
#define PG8_SB(b, h) ((4 + (b) * 2 + (h)) * HTB)
#define PG8_STAGE(bufoff, gbase, voff) do { _Pragma("unroll") for (int _i = 0; _i < 2; ++_i) \
        __builtin_amdgcn_global_load_lds((const unsigned*)((const char*)(gbase) + (voff)[_i]), (LAS unsigned*)(lds + (bufoff) + ldsw + _i * 8192), 16, 0, 0); } while (0)
    typedef int v8i_ __attribute__((ext_vector_type(8))); typedef int v4i_ __attribute__((ext_vector_type(4)));
#define PG8_LD8(dst, idx, addr) do { const v4i_ lo_ = *(const LAS v4i_*)(addr), hi_ = *(const LAS v4i_*)((addr) + 1024); dst[idx] = __builtin_shufflevector(lo_, hi_, 0, 1, 2, 3, 4, 5, 6, 7); } while (0)
#define PG8_LDA(dst, b, h) do { if constexpr (FP8) { _Pragma("unroll") for (int m = 0; m < 4; ++m) PG8_LD8(dst##8, m, lds + PG8_SA(b, h) + aoff + m * 2048); } \
        else { _Pragma("unroll") for (int m = 0; m < 4; ++m) _Pragma("unroll") for (int k = 0; k < 2; ++k) dst[m][k] = *(const LAS bf16x8*)(lds + PG8_SA(b, h) + aoff + m * 2048 + k * 1024); } } while (0)
#define PG8_LDB(dst, b, h) do { if constexpr (FP8) { _Pragma("unroll") for (int n = 0; n < 2; ++n) PG8_LD8(dst##8, n, lds + PG8_SB(b, h) + boff + n * 2048); } \
        else { _Pragma("unroll") for (int n = 0; n < 2; ++n) _Pragma("unroll") for (int k = 0; k < 2; ++k) dst[n][k] = *(const LAS bf16x8*)(lds + PG8_SB(b, h) + boff + n * 2048 + k * 1024); } } while (0)
#define PG8_MMA(ai, bj, At, Bt) do { __builtin_amdgcn_s_setprio(1); _Pragma("unroll") for (int m = 0; m < 4; ++m) _Pragma("unroll") for (int n = 0; n < 2; ++n) { \
        if constexpr (FP8) asm volatile("v_mfma_f32_16x16x128_f8f6f4 %0, %1, %2, %0" : "+v"(acc[ai][bj][m][n]) : "v"(Bt##8[n]), "v"(At##8[m]));     \
        else if constexpr (I8) { _Pragma("unroll") for (int k = 0; k < 2; ++k) asm volatile("v_mfma_i32_16x16x64_i8 %0, %1, %2, %0" : "+v"(acc[ai][bj][m][n]) : "v"(Bt[n][k]), "v"(At[m][k])); }     \
        else { _Pragma("unroll") for (int k = 0; k < 2; ++k) acc[ai][bj][m][n] = __builtin_amdgcn_mfma_f32_16x16x32_bf16(Bt[n][k], At[m][k], acc[ai][bj][m][n], 0, 0, 0); } } \
        __builtin_amdgcn_s_setprio(0); } while (0)
#define PG8_WAIT_V(n) asm volatile("s_waitcnt vmcnt(" #n ")" ::: "memory")
#define PG8_WAIT_L(n) asm volatile("s_waitcnt lgkmcnt(" #n ")" ::: "memory")
#define PG8_BAR __builtin_amdgcn_s_barrier()
#define PG8_SCHED __builtin_amdgcn_sched_barrier(0)
#define PG8_APTR(u) ((const char*)((NSEG == 1 || (u).seg == 0) ? g.A0 : ((NSEG == 2 || (u).seg == 1) ? g.A1 : g.A2)) + (size_t)(u).pm * tstepA)
#define PG8_BPTR(u) ((const char*)((NSEG == 1 || (u).seg == 0) ? g.B0 : ((NSEG == 2 || (u).seg == 1) ? g.B1 : g.B2)) + (size_t)(u).pn * tstepB)
    Unit cur, nxt; int ui = 0;
    if (!S.next(0, cur)) return;
    Acc acc; zero_acc(acc);
    bf16x8 At[4][2], B0[2][2], B1[2][2]; v8i_ At8[4], B08[2], B18[2];
    const char* cA = PG8_APTR(cur); const char* cB = PG8_BPTR(cur);
    PG8_STAGE(PG8_SB(0, 0), cB, voffB); PG8_STAGE(PG8_SB(0, 1), cB + hstepB, voffB); PG8_STAGE(PG8_SA(0, 0), cA, voffA); PG8_STAGE(PG8_SA(0, 1), cA + hstepA, voffA);
    if (wr == 1) PG8_BAR;
    PG8_WAIT_V(2); PG8_BAR;
    PG8_STAGE(PG8_SB(1, 0), cB + kstep, voffB); PG8_STAGE(PG8_SA(1, 0), cA + kstep, voffA); PG8_STAGE(PG8_SB(1, 1), cB + hstepB + kstep, voffB);
    PG8_WAIT_V(6); PG8_BAR;
    for (;;) {
        const bool has_next = S.next(ui + 1, nxt);
        const char* nA = has_next ? PG8_APTR(nxt) : cA; const char* nB = has_next ? PG8_BPTR(nxt) : cB;
#pragma unroll 1
        for (int t = 0; t < nt; t += 2) {
            const bool last = (t == nt - 2);
            const char* a1 = cA + (size_t)(t + 1) * kstep;
            const char* a2 = last ? nA : cA + (size_t)(t + 2) * kstep; const char* b2 = last ? nB : cB + (size_t)(t + 2) * kstep;
            const char* a3 = a2 + kstep; const char* b3 = b2 + kstep;
            PG8_LDB(B0, 0, 0); PG8_LDB(B1, 0, 1); PG8_SCHED; PG8_LDA(At, 0, 0); PG8_STAGE(PG8_SA(1, 1), a1 + hstepA, voffA);
            PG8_WAIT_V(8); PG8_WAIT_L(0); PG8_BAR; PG8_MMA(0, 0, At, B0); PG8_MMA(0, 1, At, B1); PG8_BAR; PG8_SCHED;
            PG8_LDA(At, 0, 1); PG8_STAGE(PG8_SB(0, 0), b2, voffB); PG8_STAGE(PG8_SB(0, 1), b2 + hstepB, voffB); PG8_STAGE(PG8_SA(0, 0), a2, voffA);
            PG8_WAIT_V(8); PG8_WAIT_L(0); PG8_BAR; PG8_MMA(1, 0, At, B0); PG8_MMA(1, 1, At, B1); PG8_BAR; PG8_SCHED;
            PG8_LDB(B0, 1, 0); PG8_LDB(B1, 1, 1); PG8_SCHED; PG8_LDA(At, 1, 0); PG8_STAGE(PG8_SA(0, 1), a2 + hstepA, voffA);
            PG8_WAIT_V(8); PG8_WAIT_L(0); PG8_BAR; PG8_MMA(0, 0, At, B0); PG8_MMA(0, 1, At, B1); PG8_BAR; PG8_SCHED;
            PG8_LDA(At, 1, 1); PG8_STAGE(PG8_SB(1, 0), b3, voffB); PG8_STAGE(PG8_SB(1, 1), b3 + hstepB, voffB); PG8_STAGE(PG8_SA(1, 0), a3, voffA);
            PG8_WAIT_V(8); PG8_WAIT_L(0); PG8_BAR; PG8_MMA(1, 0, At, B0); PG8_MMA(1, 1, At, B1); PG8_BAR; PG8_SCHED;
        }
        if (wr == 0) PG8_BAR;
        if constexpr (FP8 || I8) asm volatile("s_nop 15\n\ts_nop 15" ::: "memory");
        if constexpr (!Epi::AFTER_DRAIN) E(acc, cur, wr, wc, fr, fq);
        if (!has_next) break;
        cur = nxt; cA = nA; cB = nB; ++ui;
        if (wr == 1) PG8_BAR;
    }
    PG8_WAIT_V(0);
    PG8_BAR;
    if constexpr (Epi::AFTER_DRAIN) E.fused(acc, cur, wr, wc, fr, fq, lds, wid, lane);
#undef PG8_SA
#undef PG8_SB
#undef PG8_STAGE
#undef PG8_LDA
#undef PG8_LD8
#undef PG8_LDB
#undef PG8_MMA
#undef PG8_WAIT_V
#undef PG8_WAIT_L
#undef PG8_BAR
#undef PG8_SCHED
#undef PG8_APTR
#undef PG8_BPTR
}
}

#define XB_TMO      128
#define XB_XCNT(j)  (256  + 64 * (j))
#define XB_XSUB(j)  (1280 + 64 * (j))
#define XB_XGEN(j)  (2304 + 64 * (j))
#define XB_TOP      3328
#define XB_TOPGEN   3392
#define XCD_BAR_WORDS 3456
#define XB_SPIN_CAP (1u << 22)
__device__ __forceinline__ unsigned xb_ld(unsigned* p)              { return __hip_atomic_load(p, __ATOMIC_RELAXED, __HIP_MEMORY_SCOPE_AGENT); }
__device__ __forceinline__ unsigned xb_add(unsigned* p, unsigned v) { return __hip_atomic_fetch_add(p, v, __ATOMIC_RELAXED, __HIP_MEMORY_SCOPE_AGENT); }
__device__ __forceinline__ unsigned xb_xcc_id() { return (unsigned)__builtin_amdgcn_s_getreg((3 << 11) | 20) & 0xFu; }
#define XB_SPIN(cond, bar) do { unsigned _sp = 0; while (cond) { __builtin_amdgcn_s_sleep(1); \
    if ((++_sp & 255u) == 0u) { if (xb_ld(&(bar)[XB_TMO])) break; if (_sp > XB_SPIN_CAP) { atomicAdd(&(bar)[XB_TMO], 1u); break; } } } } while (0)
struct XcdBarrier { unsigned* bar; unsigned x; volatile LAS unsigned* st; };
__device__ __forceinline__ XcdBarrier xcd_barrier_post(unsigned* bar, volatile LAS unsigned* st, bool leader) {
    XcdBarrier b; b.bar = bar; b.x = xb_xcc_id(); b.st = st;
    if (leader) (void)xb_add(&bar[XB_XCNT(b.x)], 1u);
    return b;
}
__device__ __forceinline__ void xcd_barrier_complete(unsigned* bar, unsigned x, unsigned& nloc, unsigned& nx) {
    const unsigned G = gridDim.x * gridDim.y * gridDim.z;
    unsigned sum, cnt, mine, sp = 0u;
    for (;;) {
        sum = 0u; cnt = 0u; mine = 0u;
#pragma unroll
        for (unsigned j = 0; j < 16; ++j) { const unsigned c = xb_ld(&bar[XB_XCNT(j)]); sum += c; cnt += (c > 0u) ? 1u : 0u; mine = (j == x) ? c : mine; }
        if (sum == G) break;
        __builtin_amdgcn_s_sleep(1);
        if ((++sp & 255u) == 0u) { if (xb_ld(&bar[XB_TMO])) break; if (sp > XB_SPIN_CAP) { atomicAdd(&bar[XB_TMO], 1u); break; } }
    }
    nloc = mine > 0u ? mine : 1u; nx = cnt > 0u ? cnt : 1u;
}
__device__ __forceinline__ void xcd_barrier(const XcdBarrier& b, bool leader) {
    asm volatile("s_waitcnt vmcnt(0)" ::: "memory");
    __syncthreads();
    if (leader) {
        GAS unsigned* barg = (GAS unsigned*)b.bar; asm volatile("" : "+s"(barg)); unsigned* bar = (unsigned*)barg;
        __builtin_amdgcn_s_waitcnt(0);
        unsigned nloc = b.st[0], nx = b.st[1];
        if (nloc == 0u) { xcd_barrier_complete(bar, b.x, nloc, nx); b.st[0] = nloc; b.st[1] = nx; }
        const unsigned old = xb_add(&bar[XB_XSUB(b.x)], 1u);
        const unsigned gen = old / nloc;
        if (old + 1u == (gen + 1u) * nloc) {
            __builtin_amdgcn_fence(__ATOMIC_RELEASE, "agent");
            asm volatile("s_waitcnt vmcnt(0)" ::: "memory");
            const unsigned og = xb_add(&bar[XB_TOP], 1u);
            const unsigned tg = og / nx;
            if (og + 1u == (tg + 1u) * nx) xb_add(&bar[XB_TOPGEN], 1u);
            else XB_SPIN(xb_ld(&bar[XB_TOPGEN]) == tg, bar);
            __builtin_amdgcn_fence(__ATOMIC_ACQUIRE, "agent");
            xb_add(&bar[XB_XGEN(b.x)], 1u);
            asm volatile("s_waitcnt vmcnt(0)" ::: "memory");
        } else {
            XB_SPIN(xb_ld(&bar[XB_XGEN(b.x)]) == gen, bar);
            __builtin_amdgcn_fence(__ATOMIC_ACQUIRE, "agent");
            asm volatile("s_waitcnt vmcnt(0)" ::: "memory");
        }
    }
    __syncthreads();
}

struct Args { const float* in[24]; float* out; unsigned char* ws; int ph_lo, ph_hi; };
enum { I_X = 0, I_P, I_LNG, I_WIN, I_BIN, I_CONVW, I_CONVB, I_WA, I_BA, I_WX, I_BX, I_LAM, I_CW1, I_CW2, I_CPOS, I_NQG, I_NKG, I_FQG, I_FKG, I_WBR, I_WOUT, I_WPLE, I_PLEG, I_WPG };

#define CAS __attribute__((address_space(4)))
struct ArgsG { const GAS float* in[24]; GAS float* out; GAS unsigned char* ws; int ph_lo, ph_hi; };
static_assert(sizeof(ArgsG) == sizeof(Args), "ArgsG mirrors Args");
struct Frame {
    LAS unsigned char* lds;
    int wave, G, vcu;
    const CAS ArgsG* A;
    GAS float* out_g; GAS unsigned char* ws_g;
    float* out; unsigned char* ws;
};
__device__ __forceinline__ Frame pin(const Frame& f) { Frame g = f; asm volatile("" : "+s"(g.ws_g), "+s"(g.out_g), "+s"(g.A), "+s"(g.wave), "+s"(g.vcu)); g.ws = (unsigned char*)g.ws_g; g.out = (float*)g.out_g; return g; }
#define INP(k) ((const float*)F.A->in[k])
#define PHASE_IDS() const int lane = lane_id(); const int tid = F.wave * 64 + lane; (void)tid; (void)lane
struct LayerW { bf16 *Win, *Wbr, *Wout, *Wgate, *Wple, *Wc1, *gw, *w2t; float *bias, *posb, *posp, *sw, *sg, *so; };
__device__ __forceinline__ LayerW layer_w(unsigned char* ws, int l) {
    unsigned char* b = ws + WS_W + (size_t)l * WL_STRIDE; LayerW w;
    w.Win = (bf16*)(b + WL_IN); w.Wbr = (bf16*)(b + WL_BR); w.Wout = (bf16*)(b + WL_OUT); w.Wgate = (bf16*)(b + WL_GATE); w.Wple = (bf16*)(b + WL_PLE); w.Wc1 = (bf16*)(b + WL_C1);
    w.bias = (float*)(b + WL_MISC + WM_BIAS); w.posb = (float*)(b + WL_MISC + WM_POSB); w.posp = (float*)(b + WL_MISC + WM_POSP); w.gw = (bf16*)(b + WL_MISC + WM_GW); w.w2t = (bf16*)(b + WL_MISC + WM_W2T); w.sw = (float*)(b + WL_MISC + WM_SW); w.sg = (float*)(b + WL_MISC + WM_SG); w.so = (float*)(b + WL_MISC + WM_SO); return w;
}
#define ZP(off) ((bf16*)(F.ws + WS_Z + (off)))

template <bool REMAP>
__device__ __forceinline__ void transpose_item(const float* W, int K, int N, bf16* WT, LAS float* scr, int item, int lane, const float* kscale = nullptr) {
    const int nblk = N / 32, kb = item / nblk, nb = item % nblk, k0 = 64 * kb, n0 = 32 * nb;
#pragma unroll 8
    for (int i = 0; i < 32; ++i) { const int kk = 2 * i + (lane >> 5); float w = W[(size_t)(k0 + kk) * N + n0 + (lane & 31)]; if (REMAP) w *= kscale[k0 + kk]; scr[kk * 33 + (lane & 31)] = w; }
    LDS_WAIT(); asm volatile("" ::: "memory");
    const int c = lane & 7;
#pragma unroll
    for (int j = 0; j < 4; ++j) { const int n = (lane >> 3) + 8 * j; const LAS float* s = scr + (8 * c) * 33 + n;
        const int nn = REMAP ? nmap(n0 + n) : (n0 + n);
        { u32x4 o; o.x = pk2(s[0 * 33], s[1 * 33]); o.y = pk2(s[2 * 33], s[3 * 33]); o.z = pk2(s[4 * 33], s[5 * 33]); o.w = pk2(s[6 * 33], s[7 * 33]);
            *(u32x4*)(WT + (size_t)nn * K + k0 + 8 * c) = o; } }
    LDS_WAIT(); asm volatile("" ::: "memory");
}
__device__ __forceinline__ void fuseq_item(const Frame& F, int tid, int lane, const float* W, int N, int n0, const float* kscale, bf16* WT, float* scales, bool remap) {
    constexpr int PITCH = 4112;
    LAS unsigned char* img = F.lds;
    __syncthreads();
    const int c = tid & 31, k0 = tid >> 5;
#pragma unroll 1
    for (int ib = 0; ib < 128; ib += 16) { float v[16];
#pragma unroll
        for (int j = 0; j < 16; ++j) v[j] = W[(size_t)(k0 + 16 * (ib + j)) * N + n0 + c];
#pragma unroll
        for (int j = 0; j < 16; ++j) { const int k = k0 + 16 * (ib + j); float w = v[j]; if (kscale) w *= kscale[k];
            *(LAS unsigned short*)(img + c * PITCH + k * 2) = (unsigned short)f2bf(w); } }
    __syncthreads();
    const int wv = tid >> 6;
#pragma unroll 1
    for (int q = 0; q < 4; ++q) { const int cc = wv * 4 + q, n = n0 + cc, nn = remap ? nmap(n) : n;
        const LAS u32x4* src = (const LAS u32x4*)(img + cc * PITCH);
        u32x4 v[4]; float mx = 0.f;
#pragma unroll
        for (int j = 0; j < 4; ++j) { v[j] = src[64 * j + lane];
            mx = fmaxf(mx, fmaxf(fmaxf(fabsf(bf_lo(v[j].x)), fabsf(bf_hi(v[j].x))), fmaxf(fabsf(bf_lo(v[j].y)), fabsf(bf_hi(v[j].y)))));
            mx = fmaxf(mx, fmaxf(fmaxf(fabsf(bf_lo(v[j].z)), fabsf(bf_hi(v[j].z))), fmaxf(fabsf(bf_lo(v[j].w)), fabsf(bf_hi(v[j].w))))); }
        bf16* dst = WT + (size_t)nn * DM;
        if (remap && nn >= NIN - 32) {
#pragma unroll
            for (int j = 0; j < 4; ++j) ((u32x4*)dst)[64 * j + lane] = v[j];
            continue; }
        mx = fmaxf(mx, xlane<1>(mx)); mx = fmaxf(mx, xlane<2>(mx)); mx = fmaxf(mx, xlane<4>(mx)); mx = fmaxf(mx, xlane<8>(mx)); mx = fmaxf(mx, xlane<16>(mx));
        { auto rr = __builtin_amdgcn_permlane32_swap(__float_as_uint(mx), __float_as_uint(mx), false, false); mx = fmaxf(__uint_as_float(rr[0]), __uint_as_float(rr[1])); }
        const float sc = mx > 0.f ? mx * (1.0f / 127.0f) : 1.0f, inv = 1.0f / sc;
#pragma unroll
        for (int j = 0; j < 4; ++j) { u32x2 o;
            o.x = pk4_i8(rintf(bf_lo(v[j].x) * inv), rintf(bf_hi(v[j].x) * inv), rintf(bf_lo(v[j].y) * inv), rintf(bf_hi(v[j].y) * inv));
            o.y = pk4_i8(rintf(bf_lo(v[j].z) * inv), rintf(bf_hi(v[j].z) * inv), rintf(bf_lo(v[j].w) * inv), rintf(bf_hi(v[j].w) * inv));
            ((u32x2*)dst)[64 * j + lane] = o; }
        if (lane == 0) scales[nn] = sc; }
}
__device__ __forceinline__ void phase_prologue(const Frame& F0) {
    const Frame F = pin(F0); PHASE_IDS();
    LAS float* scr = (LAS float*)(F.lds + F.wave * 16384);
    const int gw = F.vcu * NWAVES + F.wave, NGW = F.G * NWAVES;
    constexpr int I_IN = (DM / 64) * (NIN / 32), I_BR = (BW / 64) * (DM / 32), I_SQ = (DM / 64) * (DM / 32), I_PL = (PLE / 64) * (DM / 32), I_C1 = (4096 / 64) * (CMPH / 32);
    constexpr int PER_LAYER = I_IN + 3 * I_BR + 2 * I_SQ + I_PL + 2 * I_C1;
    for (int it = gw; it < DEPTH * PER_LAYER; it += NGW) {
        const int l = it / PER_LAYER; int r = it - l * PER_LAYER; const LayerW w = layer_w(F.ws, l);
        if (r < I_IN) { if (!P0_FUSEQ) transpose_item<true>(INP(I_WIN) + (size_t)l * DM * NIN, DM, NIN, w.Win, scr, r, lane, INP(I_LNG) + (size_t)l * DM); continue; } r -= I_IN;
        if (r < 3 * I_BR) { const int i = r / I_BR; transpose_item<false>(INP(I_WBR) + ((size_t)l * 3 + i) * BW * DM, BW, DM, w.Wbr + (size_t)i * DM * BW, scr, r - i * I_BR, lane); continue; } r -= 3 * I_BR;
        if (r < I_SQ) { if (!(P0_FUSEQ && I8_P6)) transpose_item<false>(INP(I_WOUT) + (size_t)l * DM * DM, DM, DM, w.Wout, scr, r, lane); continue; } r -= I_SQ;
        if (r < I_SQ) { if (!(P0_FUSEQ && I8_P7)) transpose_item<false>(INP(I_WPG) + (size_t)l * DM * DM, DM, DM, w.Wgate, scr, r, lane); continue; } r -= I_SQ;
        if (r < I_PL) { transpose_item<false>(INP(I_WPLE) + (size_t)l * PLE * DM, PLE, DM, w.Wple, scr, r, lane); continue; } r -= I_PL;
        { const int j = r / I_C1; transpose_item<false>(INP(I_CW1) + ((size_t)l * 2 + j) * 4096 * CMPH, 4096, CMPH, w.Wc1 + (size_t)j * CMPH * 4096, scr, r - j * I_C1, lane); }
    }
    const int gt = F.vcu * NTHREADS + tid, NGT = F.G * NTHREADS;
    for (int l = 0; l < DEPTH; ++l) {
        const LayerW w = layer_w(F.ws, l);
        u32x4* z = (u32x4*)(w.Win + (size_t)NIN * DM);
        for (int i = gt; i < (NINP - NIN) * DM / 8; i += NGT) z[i] = (u32x4){0u, 0u, 0u, 0u};
        for (int i = gt; i < NINP; i += NGT) if (i >= NIN) w.bias[i] = 0.f;
        for (int i = gt; i < NIN; i += NGT) w.bias[nmap(i)] = INP(I_BIN)[(size_t)l * NIN + i];
    }
    { const f32x4* p4 = (const f32x4*)INP(I_P); u32x2* o = (u32x2*)(F.ws + WS_PB);
      for (size_t i = gt; i < (size_t)DEPTH * T * PLE / 4; i += NGT) { const f32x4 v = p4[i]; u32x2 w; w.x = pk2(v.x, v.y); w.y = pk2(v.z, v.w); o[i] = w; } }
    for (int l = 0; l < DEPTH; ++l) { const LayerW w = layer_w(F.ws, l);
        for (int i = gt; i < 2 * 128 * 256; i += NGT) { const int j = i >> 15, d = (i >> 8) & 127, k = i & 255;
            w.w2t[i] = (bf16)f2bf(INP(I_CW2)[(((size_t)l * 2 + j) * CMPH + k) * HD + d]); } }
    for (int l = 0; l < DEPTH; ++l) { const LayerW w = layer_w(F.ws, l);
        for (int i = gt; i < 2 * 16 * 4096; i += NGT) { const int mtx = i >> 16, n = (i >> 12) & 15, j = (i >> 6) & 63, k = i & 63;
            w.gw[i] = (bf16)f2bf((mtx ? INP(I_WX) : INP(I_WA))[((size_t)l * 16 + n) * 4096 + k * 64 + j]); } }
    for (int it = gw; it < DEPTH * 2 * 16 * 4; it += NGW) {
        const int q = it & 3, c = (it >> 2) & 15, j = (it >> 6) & 1, l = it >> 7; const LayerW w = layer_w(F.ws, l);
        const float* pos = INP(I_CPOS) + ((size_t)l * 2 + j) * 4096 + c * 256;
        const float* w1 = INP(I_CW1) + (((size_t)l * 2 + j) * 4096 + c * 256) * CMPH + q * 64 + lane;
        float s = 0.f;
#pragma unroll 8
        for (int i = 0; i < 256; ++i) s += pos[i] * w1[(size_t)i * CMPH];
        w.posp[(j * 16 + c) * 256 + q * 64 + lane] = s;
    }
    if (P0_FUSEQ) {
        constexpr int NI_IN = NIN / 32, NI_SQ = DM / 32, PER = NI_IN + (I8_P6 ? NI_SQ : 0) + (I8_P7 ? NI_SQ : 0);
        static_assert(NIN % 32 == 0, "whole 32-column items");
        for (int it = F.vcu; it < DEPTH * PER; it += F.G) { const int l = it / PER; int r = it - l * PER; const LayerW w = layer_w(F.ws, l);
            if (r < NI_IN) { fuseq_item(F, tid, lane, INP(I_WIN) + (size_t)l * DM * NIN, NIN, r * 32, INP(I_LNG) + (size_t)l * DM, w.Win, w.sw, true); continue; } r -= NI_IN;
            if (I8_P6 && r < NI_SQ) { fuseq_item(F, tid, lane, INP(I_WOUT) + (size_t)l * DM * DM, DM, r * 32, nullptr, w.Wout, w.so, false); continue; } if (I8_P6) r -= NI_SQ;
            fuseq_item(F, tid, lane, INP(I_WPG) + (size_t)l * DM * DM, DM, r * 32, nullptr, w.Wgate, w.sg, false); }
    }
    { bf16* hb = (bf16*)(F.ws + WS_X2); float* PS = (float*)(F.ws + WS_PS); const float* x = INP(I_X);
      unsigned char* a8 = F.ws + WS_A8; float* sa = (float*)(F.ws + WS_RSE);
      for (int m = gw; m < T; m += NGW) { const f32x4* xr = (const f32x4*)(x + (size_t)m * DM) + lane; u32x2* o = (u32x2*)(hb + (size_t)m * DM) + lane; float ssq = 0.f, mx = 0.f;
          u32x2 wb[8];
#pragma unroll
          for (int j = 0; j < 8; ++j) { const f32x4 v = xr[64 * j]; ssq += (v.x * v.x + v.y * v.y) + (v.z * v.z + v.w * v.w); u32x2 w; w.x = pk2(v.x, v.y); w.y = pk2(v.z, v.w); o[64 * j] = w; wb[j] = w;
              mx = fmaxf(mx, fmaxf(fmaxf(fabsf(bf_lo(w.x)), fabsf(bf_hi(w.x))), fmaxf(fabsf(bf_lo(w.y)), fabsf(bf_hi(w.y))))); }
          ssq = wave_sum(ssq); if (lane < 8) PS[(size_t)m * 8 + lane] = lane == 0 ? ssq : 0.f;
          mx = fmaxf(mx, xlane<1>(mx)); mx = fmaxf(mx, xlane<2>(mx)); mx = fmaxf(mx, xlane<4>(mx)); mx = fmaxf(mx, xlane<8>(mx)); mx = fmaxf(mx, xlane<16>(mx));
          { auto rr = __builtin_amdgcn_permlane32_swap(__float_as_uint(mx), __float_as_uint(mx), false, false); mx = fmaxf(__uint_as_float(rr[0]), __uint_as_float(rr[1])); }
          const float sc = mx > 0.f ? mx * (1.0f / 127.0f) : 1.0f, inv = 1.0f / sc;
          unsigned* o8 = (unsigned*)(a8 + (size_t)m * DM) + lane;
#pragma unroll
          for (int j = 0; j < 8; ++j) o8[64 * j] = pk4_i8(rintf(bf_lo(wb[j].x) * inv), rintf(bf_hi(wb[j].x) * inv), rintf(bf_lo(wb[j].y) * inv), rintf(bf_hi(wb[j].y) * inv));
          if (lane == 0) sa[m] = sc; } }
}


__device__ __forceinline__ float quant_row(const bf16* src, unsigned char* dst, int lane) {
    u32x4 v[4]; float mx = 0.f;
#pragma unroll
    for (int j = 0; j < 4; ++j) { v[j] = ((const u32x4*)src)[64 * j + lane];
        mx = fmaxf(mx, fmaxf(fmaxf(fabsf(bf_lo(v[j].x)), fabsf(bf_hi(v[j].x))), fmaxf(fabsf(bf_lo(v[j].y)), fabsf(bf_hi(v[j].y)))));
        mx = fmaxf(mx, fmaxf(fmaxf(fabsf(bf_lo(v[j].z)), fabsf(bf_hi(v[j].z))), fmaxf(fabsf(bf_lo(v[j].w)), fabsf(bf_hi(v[j].w))))); }
    mx = fmaxf(mx, xlane<1>(mx)); mx = fmaxf(mx, xlane<2>(mx)); mx = fmaxf(mx, xlane<4>(mx)); mx = fmaxf(mx, xlane<8>(mx)); mx = fmaxf(mx, xlane<16>(mx));
    { auto rr = __builtin_amdgcn_permlane32_swap(__float_as_uint(mx), __float_as_uint(mx), false, false); mx = fmaxf(__uint_as_float(rr[0]), __uint_as_float(rr[1])); }
    const float sc = mx > 0.f ? mx * (1.0f / 127.0f) : 1.0f, inv = 1.0f / sc;
    asm volatile("" ::: "memory");
#pragma unroll
    for (int j = 0; j < 4; ++j) { u32x2 o;
        o.x = pk4_i8(rintf(bf_lo(v[j].x) * inv), rintf(bf_hi(v[j].x) * inv), rintf(bf_lo(v[j].y) * inv), rintf(bf_hi(v[j].y) * inv));
        o.y = pk4_i8(rintf(bf_lo(v[j].z) * inv), rintf(bf_hi(v[j].z) * inv), rintf(bf_lo(v[j].w) * inv), rintf(bf_hi(v[j].w) * inv));
        ((u32x2*)dst)[64 * j + lane] = o; }
    return sc;
}
__device__ __forceinline__ void phase_quant_w(const Frame& F0) {
    const Frame F = pin(F0); PHASE_IDS();
    const int gw = F.vcu * NWAVES + F.wave, NGW = F.G * NWAVES;
    for (int it = gw; it < DEPTH * (NIN - 32); it += NGW) { const int l = it / (NIN - 32), n = it - l * (NIN - 32); const LayerW w = layer_w(F.ws, l);
        const float sc = quant_row(w.Win + (size_t)n * DM, (unsigned char*)(w.Win + (size_t)n * DM), lane); if (lane == 0) w.sw[n] = sc; }
    if (I8_P7) for (int it = gw; it < DEPTH * DM; it += NGW) { const int l = it / DM, n = it - l * DM; const LayerW w = layer_w(F.ws, l);
        const float sc = quant_row(w.Wgate + (size_t)n * DM, (unsigned char*)(w.Wgate + (size_t)n * DM), lane); if (lane == 0) w.sg[n] = sc; }
    if (I8_P6) for (int it = gw; it < DEPTH * DM; it += NGW) { const int l = it / DM, n = it - l * DM; const LayerW w = layer_w(F.ws, l);
        const float sc = quant_row(w.Wout + (size_t)n * DM, (unsigned char*)(w.Wout + (size_t)n * DM), lane); if (lane == 0) w.so[n] = sc; }
}
__device__ __forceinline__ void phase_quant_a(const Frame& F0, size_t src_off = WS_X2, size_t dst_off = WS_A8, size_t sc_off = WS_RSE) {
    const Frame F = pin(F0); PHASE_IDS();
    const int gw = F.vcu * NWAVES + F.wave, NGW = F.G * NWAVES;
    const bf16* hb = (const bf16*)(F.ws + src_off); unsigned char* a8 = F.ws + dst_off; float* sa = (float*)(F.ws + sc_off);
    for (int m = gw; m < T; m += 2 * NGW) {
        const int m1 = m + NGW;
        u32x4 v[2][4]; float mx[2];
#pragma unroll
        for (int q = 0; q < 2; ++q)
#pragma unroll
            for (int j = 0; j < 4; ++j) v[q][j] = ((const u32x4*)(hb + (size_t)(q ? m1 : m) * DM))[64 * j + lane];
#pragma unroll
        for (int q = 0; q < 2; ++q) { float x = 0.f;
#pragma unroll
            for (int j = 0; j < 4; ++j) { x = fmaxf(x, fmaxf(fmaxf(fabsf(bf_lo(v[q][j].x)), fabsf(bf_hi(v[q][j].x))), fmaxf(fabsf(bf_lo(v[q][j].y)), fabsf(bf_hi(v[q][j].y)))));
                x = fmaxf(x, fmaxf(fmaxf(fabsf(bf_lo(v[q][j].z)), fabsf(bf_hi(v[q][j].z))), fmaxf(fabsf(bf_lo(v[q][j].w)), fabsf(bf_hi(v[q][j].w))))); }
            x = fmaxf(x, xlane<1>(x)); x = fmaxf(x, xlane<2>(x)); x = fmaxf(x, xlane<4>(x)); x = fmaxf(x, xlane<8>(x)); x = fmaxf(x, xlane<16>(x));
            { auto rr = __builtin_amdgcn_permlane32_swap(__float_as_uint(x), __float_as_uint(x), false, false); x = fmaxf(__uint_as_float(rr[0]), __uint_as_float(rr[1])); }
            mx[q] = x; }
#pragma unroll
        for (int q = 0; q < 2; ++q) { const float sc = mx[q] > 0.f ? mx[q] * (1.0f / 127.0f) : 1.0f, inv = 1.0f / sc; const int mq = q ? m1 : m;
#pragma unroll
            for (int j = 0; j < 4; ++j) { u32x2 o;
                o.x = pk4_i8(rintf(bf_lo(v[q][j].x) * inv), rintf(bf_hi(v[q][j].x) * inv), rintf(bf_lo(v[q][j].y) * inv), rintf(bf_hi(v[q][j].y) * inv));
                o.y = pk4_i8(rintf(bf_lo(v[q][j].z) * inv), rintf(bf_hi(v[q][j].z) * inv), rintf(bf_lo(v[q][j].w) * inv), rintf(bf_hi(v[q][j].w) * inv));
                ((u32x2*)(a8 + (size_t)mq * DM))[64 * j + lane] = o; }
            if (lane == 0) sa[mq] = sc; }
    }
}
struct Dst { bf16* base; int pitch; long bjs; int act; const float* gain; };
enum { ACT_NONE = 0, ACT_SILU = 1, ACT_NORM = 2, ACT_EXPG = 3, ACT_SIGU8 = 4 };

__device__ __forceinline__ void store_tile(pg8::Acc& acc, const Dst& d, LAS float* red, int wr, int wc, int fr, int fq) {
    if (d.act == ACT_NORM) {
#pragma unroll
        for (int ai = 0; ai < 2; ++ai)
#pragma unroll
            for (int m = 0; m < 4; ++m)
#pragma unroll
                for (int bj = 0; bj < 2; ++bj) { const f32x4 a = acc[ai][bj][m][0], b = acc[ai][bj][m][1];
                    float s = (a.x * a.x + a.y * a.y) + (a.z * a.z + a.w * a.w) + (b.x * b.x + b.y * b.y) + (b.z * b.z + b.w * b.w);
                    s += xlane<16>(s); s = xsum32(s);
                    if (fq == 0) red[((ai * 128 + wr * 64 + m * 16 + fr) * 2 + bj) * 4 + wc] = s; }
        LDS_WAIT(); __builtin_amdgcn_s_barrier(); asm volatile("" ::: "memory");
    }
    f32x4 g0 = (f32x4){1.f, 1.f, 1.f, 1.f}, g1 = g0;
    if (d.act == ACT_NORM) { g0 = *(const f32x4*)(d.gain + wc * 32 + 8 * fq); g1 = *(const f32x4*)(d.gain + wc * 32 + 8 * fq + 4); }
#pragma unroll
    for (int ai = 0; ai < 2; ++ai)
#pragma unroll
        for (int m = 0; m < 4; ++m) { int rr = ai * 128 + wr * 64 + m * 16 + fr; asm volatile("" : "+v"(rr));
#pragma unroll
            for (int bj = 0; bj < 2; ++bj) { f32x4 v0 = acc[ai][bj][m][0], v1 = acc[ai][bj][m][1];
                if (d.act == ACT_NORM) { const f32x4 r4 = *(const LAS f32x4*)(red + (rr * 2 + bj) * 4);
                    const float rstd = 1.0f / sqrtf(((r4.x + r4.y) + (r4.z + r4.w)) * (1.f / HD) + EPS); v0 = v0 * rstd * g0; v1 = v1 * rstd * g1; }
                if (d.act == ACT_SILU) {
#pragma unroll
                    for (int i = 0; i < 4; ++i) { v0[i] = v0[i] * sigmoidf_(v0[i]); v1[i] = v1[i] * sigmoidf_(v1[i]); } }
                if (d.act == ACT_EXPG) {
#pragma unroll
                    for (int i = 0; i < 4; ++i) { v0[i] = 1.0f + __builtin_amdgcn_exp2f(-1.4426950408889634f * fminf(fmaxf(v0[i], -30.f), 30.f)); v1[i] = 1.0f + __builtin_amdgcn_exp2f(-1.4426950408889634f * fminf(fmaxf(v1[i], -30.f), 30.f)); } }
                if (d.act == ACT_SIGU8) {
                    unsigned q[2] = {0u, 0u};
#pragma unroll
                    for (int i = 0; i < 4; ++i) { const float m0 = __builtin_amdgcn_rcpf(1.0f + __builtin_amdgcn_exp2f(-1.4426950408889634f * v0[i])), m1 = __builtin_amdgcn_rcpf(1.0f + __builtin_amdgcn_exp2f(-1.4426950408889634f * v1[i]));
                        const unsigned u0 = (unsigned)fmaxf(m0 * 255.0f + 0.5f, 1.0f), u1 = (unsigned)fmaxf(m1 * 255.0f + 0.5f, 1.0f);
                        q[0] |= u0 << (8 * i); q[1] |= u1 << (8 * i); }
                    u32x2 w8; w8.x = q[0]; w8.y = q[1];
                    *(u32x2*)((unsigned char*)d.base + bj * d.bjs + (size_t)rr * d.pitch + wc * 32 + 8 * fq) = w8;
                    continue; }
                u32x4 w; w.x = cvt_pk_bf16(v0[0], v0[1]); w.y = cvt_pk_bf16(v0[2], v0[3]); w.z = cvt_pk_bf16(v1[0], v1[1]); w.w = cvt_pk_bf16(v1[2], v1[3]);
                *(u32x4*)(d.base + bj * d.bjs + (size_t)rr * d.pitch + wc * 32 + 8 * fq) = w; }
            asm volatile("" ::: "memory"); }
}
__device__ __forceinline__ void add_bias(pg8::Acc& acc, const float* bias, int col0) {
#pragma unroll
    for (int bj = 0; bj < 2; ++bj)
#pragma unroll
        for (int n = 0; n < 2; ++n) { const f32x4 bv = *(const f32x4*)(bias + col0 + bj * 128 + 4 * n);
#pragma unroll
            for (int ai = 0; ai < 2; ++ai)
#pragma unroll
                for (int m = 0; m < 4; ++m) acc[ai][bj][m][n] += bv; }
}

struct EpiIn {
    static constexpr bool AFTER_DRAIN = false;
    unsigned char* ws; const float* bias; const float *g_nq, *g_nk, *g_fq, *g_fk; LAS float* red; const float* PS; int* cur_pm; bool plain; int pn0; float wscale; const float* SA; const float* SW; bool i8;
    __device__ __forceinline__ void operator()(pg8::Acc& acc, const pg8::Unit& u, int wr, int wc, int fr, int fq) const {
        if (i8) {
#pragma unroll
            for (int ai = 0; ai < 2; ++ai)
#pragma unroll
                for (int bj = 0; bj < 2; ++bj)
#pragma unroll
                    for (int m = 0; m < 4; ++m)
#pragma unroll
                        for (int n = 0; n < 2; ++n) { const f32x4 a = acc[ai][bj][m][n];
                            acc[ai][bj][m][n] = (f32x4){(float)__float_as_int(a.x), (float)__float_as_int(a.y), (float)__float_as_int(a.z), (float)__float_as_int(a.w)}; } }
        LAS float* rsl = red + 2048;
        if (u.pm != *cur_pm) { *cur_pm = u.pm;
            const int t2 = (wr * 4 + wc) * 64 + fq * 16 + fr;
            if (t2 < 256) { const float* pp = PS + ((size_t)u.pm * 256 + t2) * 8; const f32x4 q0 = *(const f32x4*)pp, q1 = *(const f32x4*)(pp + 4);
                rsl[t2] = SA[(size_t)u.pm * 256 + t2] / sqrtf((((q0.x + q0.y) + (q0.z + q0.w)) + ((q1.x + q1.y) + (q1.z + q1.w))) * (1.f / DM) + EPS); }
            LDS_WAIT(); __builtin_amdgcn_s_barrier(); asm volatile("" ::: "memory"); }
#pragma unroll
        for (int ai = 0; ai < 2; ++ai)
#pragma unroll
            for (int m = 0; m < 4; ++m) { const float rs = rsl[ai * 128 + wr * 64 + m * 16 + fr] * wscale;
#pragma unroll
                for (int bj = 0; bj < 2; ++bj) { acc[ai][bj][m][0] *= rs; acc[ai][bj][m][1] *= rs; } }
        const int pn = u.pn + pn0, b = u.pm >> 4, s0 = (u.pm & 15) * 256;
#pragma unroll
        for (int bj = 0; bj < 2; ++bj) { const f32x4 c0 = *(const f32x4*)(SW + pn * 256 + bj * 128 + wc * 32 + 8 * fq), c1 = *(const f32x4*)(SW + pn * 256 + bj * 128 + wc * 32 + 8 * fq + 4);
#pragma unroll
            for (int ai = 0; ai < 2; ++ai)
#pragma unroll
                for (int m = 0; m < 4; ++m) { acc[ai][bj][m][0] *= c0; acc[ai][bj][m][1] *= c1; } }
        add_bias(acc, bias, pn * 256 + wc * 32 + 8 * fq);
        if (pn == 62) {
            if (wc == 0) { float* BG = (float*)(ws + WS_Z + Z_BG); float* LF = (float*)(ws + WS_Z + Z_LF);
#pragma unroll
                for (int ai = 0; ai < 2; ++ai)
#pragma unroll
                    for (int m = 0; m < 4; ++m) { const size_t row = (size_t)u.pm * 256 + ai * 128 + wr * 64 + m * 16 + fr;
#pragma unroll
                        for (int n = 0; n < 2; ++n)
#pragma unroll
                            for (int i = 0; i < 4; ++i) { const int col = 8 * fq + 4 * n + i; const float v = acc[ai][0][m][n][i];
                                if (col < 24) BG[row * 24 + col] = sigmoidf_(v);
                                else LF[row * 8 + (col - 24)] = (v >= 0.f) ? -log1pf(__expf(-v)) : (v - log1pf(__expf(v))); } } }
            pg8::zero_acc(acc); return;
        }
        Dst d; d.gain = nullptr; d.act = ACT_NONE;
#define TM(off, W_, ct) do { d.base = (bf16*)(ws + WS_Z + (off)) + (size_t)u.pm * 256 * (W_) + (ct) * 256; d.pitch = (W_); d.bjs = 128; } while (0)
#define HM(off, NH_, h0) do { d.base = (bf16*)(ws + WS_Z + (off)) + ((size_t)(b * (NH_) + (h0)) * SEQ + s0) * HD; d.pitch = HD; d.bjs = (long)SEQ * HD; } while (0)
        if (pn < 4) { TM(Z_U, BW, pn); }
        else if (pn < 8) { TM(Z_GA, BW, pn - 4); d.act = ACT_SILU; }
        else if (pn < 12) { HM(Z_QN, 8, (pn - 8) * 2); d.act = ACT_NORM; d.gain = g_nq; }
        else if (pn == 12) { HM(Z_KC, 2, 0); }
        else if (pn == 13) { HM(Z_VC, 2, 0); }
        else if (pn == 14) { HM(Z_KS, 2, 0); d.act = ACT_NORM; d.gain = g_nk; }
        else if (pn == 15) { HM(Z_VS, 2, 0); }
        else if (pn == 16) { HM(Z_KW, 2, 0); d.act = ACT_NORM; d.gain = g_nk; }
        else if (pn == 17) { HM(Z_VW, 2, 0); }
        else if (pn < 22) { TM(Z_GB, BW, pn - 18); d.act = ACT_SILU; }
        else if (pn < 26) { HM(Z_QF, 8, (pn - 22) * 2); d.act = ACT_NORM; d.gain = g_fq; }
        else if (pn < 30) { HM(Z_KF, 8, (pn - 26) * 2); d.act = ACT_NORM; d.gain = g_fk; }
        else if (pn < 34) { HM(Z_VF, 8, (pn - 30) * 2); }
        else if (pn < 38) { TM(Z_GC, BW, pn - 34); d.act = ACT_SILU; }
        else { d.base = (bf16*)(ws + WS_Z + Z_MG + (size_t)u.pm * 256 * (3 * DM) + (size_t)(pn - 38) * 256); d.pitch = 3 * DM; d.bjs = 128; d.act = ACT_SIGU8; }
#undef TM
#undef HM
        if (plain) d.act = ACT_NONE;
        store_tile(acc, d, red, wr, wc, fr, fq);
        pg8::zero_acc(acc);
    }
};
struct EpiStore {
    static constexpr bool AFTER_DRAIN = false;
    bf16* O0; bf16* O1; int ldc; const float* bias0; const float* bias1; int act;
    __device__ __forceinline__ void operator()(pg8::Acc& acc, const pg8::Unit& u, int wr, int wc, int fr, int fq) const {
        const float* bias = u.seg ? bias1 : bias0;
        if (bias) add_bias(acc, bias, u.pn * 256 + wc * 32 + 8 * fq);
        Dst d; d.base = (u.seg ? O1 : O0) + (size_t)u.pm * 256 * ldc + u.pn * 256; d.pitch = ldc; d.bjs = 128; d.act = act; d.gain = nullptr;
        store_tile(acc, d, nullptr, wr, wc, fr, fq);
        pg8::zero_acc(acc);
    }
};

struct EpiCmp {
    static constexpr bool AFTER_DRAIN = true;
    const float* posb; const bf16* w2t; const float* gk; bf16* KC; bf16* VC;
    __device__ __forceinline__ void operator()(pg8::Acc&, const pg8::Unit&, int, int, int, int) const {}
    __device__ __forceinline__ void fused(pg8::Acc& acc, const pg8::Unit& u, int wr, int wc, int fr, int fq, LAS unsigned char* lds, int wid, int lane) const {
        typedef float f32x16 __attribute__((ext_vector_type(16)));
        constexpr int HP = 264;
        LAS bf16* hid = (LAS bf16*)lds;
        const int j = u.seg;
        add_bias(acc, posb + j * 256, wc * 32 + 8 * fq);
#pragma unroll
        for (int ai = 0; ai < 2; ++ai)
#pragma unroll
            for (int m = 0; m < 4; ++m) { const int rr = ai * 128 + wr * 64 + m * 16 + fr;
#pragma unroll
                for (int bj = 0; bj < 2; ++bj) { f32x4 v0 = acc[ai][bj][m][0], v1 = acc[ai][bj][m][1];
#pragma unroll
                    for (int i = 0; i < 4; ++i) { v0[i] = v0[i] * sigmoidf_(v0[i]); v1[i] = v1[i] * sigmoidf_(v1[i]); }
                    u32x4 w; w.x = cvt_pk_bf16(v0[0], v0[1]); w.y = cvt_pk_bf16(v0[2], v0[3]); w.z = cvt_pk_bf16(v1[0], v1[1]); w.w = cvt_pk_bf16(v1[2], v1[3]);
                    *(LAS u32x4*)(hid + rr * HP + bj * 128 + wc * 32 + 8 * fq) = w; } }
        LDS_WAIT(); __builtin_amdgcn_s_barrier(); asm volatile("" ::: "memory");
        const int r32 = lane & 31, hi = lane >> 5;
        f32x16 o[4] = {};
        const bf16* wt = w2t + (size_t)j * 128 * 256;
#pragma unroll 4
        for (int ks = 0; ks < 16; ++ks) { const bf16x8 af = *(const LAS bf16x8*)(hid + (wid * 32 + r32) * HP + ks * 16 + hi * 8);
#pragma unroll
            for (int ct = 0; ct < 4; ++ct) { const bf16x8 bfr = *(const bf16x8*)(wt + (size_t)(ct * 32 + r32) * 256 + ks * 16 + hi * 8);
                o[ct] = __builtin_amdgcn_mfma_f32_32x32x16_bf16(af, bfr, o[ct], 0, 0, 0); } }
        float g4[4] = {1.f, 1.f, 1.f, 1.f};
        if (j == 0) {
#pragma unroll
            for (int ct = 0; ct < 4; ++ct) g4[ct] = gk[ct * 32 + r32]; }
        bf16* O = (j ? VC : KC) + ((size_t)u.pm * 256 + wid * 32) * HD + r32;
#pragma unroll
        for (int r = 0; r < 16; ++r) { const int row = (r & 3) + 8 * (r >> 2) + 4 * hi; float sc = 1.f;
            if (j == 0) { float ss = (o[0][r] * o[0][r] + o[1][r] * o[1][r]) + (o[2][r] * o[2][r] + o[3][r] * o[3][r]);
                ss += xlane<1>(ss); ss += xlane<2>(ss); ss += xlane<4>(ss); ss += xlane<8>(ss); ss += xlane<16>(ss);
                sc = 1.0f / sqrtf(ss * (1.f / HD) + EPS); }
            if (wid * 32 + row == 255) sc = 0.f;
#pragma unroll
            for (int ct = 0; ct < 4; ++ct) O[(size_t)row * HD + ct * 32] = (bf16)f2bf(o[ct][r] * sc * g4[ct]); }
    }
};

struct EpiEraw {
    static constexpr bool AFTER_DRAIN = false;
    bf16* O; float* PSE; LAS float* red;
    __device__ __forceinline__ void operator()(pg8::Acc& acc, const pg8::Unit& u, int wr, int wc, int fr, int fq) const {
#pragma unroll
        for (int ai = 0; ai < 2; ++ai)
#pragma unroll
            for (int m = 0; m < 4; ++m) { const int rr = ai * 128 + wr * 64 + m * 16 + fr; float ssq = 0.f;
#pragma unroll
                for (int bj = 0; bj < 2; ++bj) { const f32x4 v0 = acc[ai][bj][m][0], v1 = acc[ai][bj][m][1];
                    ssq += ((v0.x * v0.x + v0.y * v0.y) + (v0.z * v0.z + v0.w * v0.w)) + ((v1.x * v1.x + v1.y * v1.y) + (v1.z * v1.z + v1.w * v1.w));
                    u32x4 w; w.x = cvt_pk_bf16(v0[0], v0[1]); w.y = cvt_pk_bf16(v0[2], v0[3]); w.z = cvt_pk_bf16(v1[0], v1[1]); w.w = cvt_pk_bf16(v1[2], v1[3]);
                    *(u32x4*)(O + ((size_t)u.pm * 256 + rr) * DM + u.pn * 256 + bj * 128 + wc * 32 + 8 * fq) = w; }
                ssq += xlane<16>(ssq); ssq = xsum32(ssq);
                if (fq == 0) red[rr * 4 + wc] = ssq; }
        LDS_WAIT(); __builtin_amdgcn_s_barrier(); asm volatile("" ::: "memory");
        { const int t2 = (wr * 4 + wc) * 64 + fq * 16 + fr;
          if (t2 < 256) { const f32x4 r4 = *(const LAS f32x4*)(red + t2 * 4); PSE[((size_t)u.pm * 256 + t2) * 8 + u.pn] = (r4.x + r4.y) + (r4.z + r4.w); } }
        LDS_WAIT(); __builtin_amdgcn_s_barrier(); asm volatile("" ::: "memory");
        pg8::zero_acc(acc);
    }
};
struct EpiBranch {
    static constexpr bool AFTER_DRAIN = false;
    const unsigned char* MG; bf16* O;
    __device__ __forceinline__ void operator()(pg8::Acc& acc, const pg8::Unit& u, int wr, int wc, int fr, int fq) const {
        const int seg = u.seg;
        const unsigned char* mgp = MG + ((size_t)u.pm * 256 + wr * 64 + fr) * (3 * DM) + seg * DM + u.pn * 256 + wc * 32 + 8 * fq;
        u32x2 ea[2][4][2], eb[2][4][2];
#pragma unroll
        for (int ai = 0; ai < 2; ++ai)
#pragma unroll
            for (int m = 0; m < 4; ++m)
#pragma unroll
                for (int bj = 0; bj < 2; ++bj) { const unsigned char* p = mgp + (size_t)(ai * 128 + m * 16) * (3 * DM) + bj * 128;
                    ea[ai][m][bj] = *(const u32x2*)p;
                    eb[ai][m][bj] = (seg < 2) ? *(const u32x2*)(p + DM) : (u32x2){0xffffffffu, 0xffffffffu}; }
        asm volatile("" ::: "memory");
#pragma unroll
        for (int ai = 0; ai < 2; ++ai)
#pragma unroll
            for (int m = 0; m < 4; ++m) {
                const int rr = ai * 128 + wr * 64 + m * 16 + fr;
#pragma unroll
                for (int bj = 0; bj < 2; ++bj) { const u32x2 a = ea[ai][m][bj], b = eb[ai][m][bj];
                    f32x4 f0, f1;
#pragma unroll
                    for (int i = 0; i < 4; ++i) { f0[i] = (float)((a.x >> (8 * i)) & 0xffu) * __builtin_amdgcn_rcpf((float)((b.x >> (8 * i)) & 0xffu)); f1[i] = (float)((a.y >> (8 * i)) & 0xffu) * __builtin_amdgcn_rcpf((float)((b.y >> (8 * i)) & 0xffu)); }
                    const f32x4 v0 = acc[ai][bj][m][0] * f0, v1 = acc[ai][bj][m][1] * f1;
                    if (seg < 2) { acc[ai][bj][m][0] = v0; acc[ai][bj][m][1] = v1; }
                    else { u32x4 w; w.x = cvt_pk_bf16(v0[0], v0[1]); w.y = cvt_pk_bf16(v0[2], v0[3]); w.z = cvt_pk_bf16(v1[0], v1[1]); w.w = cvt_pk_bf16(v1[2], v1[3]);
                        *(u32x4*)(O + ((size_t)u.pm * 256 + rr) * DM + u.pn * 256 + bj * 128 + wc * 32 + 8 * fq) = w;
                        acc[ai][bj][m][0] = (f32x4){0.f, 0.f, 0.f, 0.f}; acc[ai][bj][m][1] = (f32x4){0.f, 0.f, 0.f, 0.f}; } }
                if (seg == 2) asm volatile("" ::: "memory"); }
    }
};
struct EpiOut {
    static constexpr bool AFTER_DRAIN = false;
    const float* hsrc; const bf16* hsb; bf16* hb; const float* sa; const float* so;
    __device__ __forceinline__ void operator()(pg8::Acc& acc, const pg8::Unit& u, int wr, int wc, int fr, int fq) const {
        f32x4 cs[2][2];
#pragma unroll
        for (int bj = 0; bj < 2; ++bj) { if (I8_P6) { cs[bj][0] = *(const f32x4*)(so + u.pn * 256 + bj * 128 + wc * 32 + 8 * fq); cs[bj][1] = *(const f32x4*)(so + u.pn * 256 + bj * 128 + wc * 32 + 8 * fq + 4); }
            else { cs[bj][0] = (f32x4){1.f, 1.f, 1.f, 1.f}; cs[bj][1] = cs[bj][0]; } }
#pragma unroll
        for (int ai = 0; ai < 2; ++ai)
#pragma unroll
            for (int mp = 0; mp < 2; ++mp) {
                int rr = ai * 128 + wr * 64 + mp * 32 + fr; asm volatile("" : "+v"(rr));
                const size_t o0 = ((size_t)u.pm * 256 + rr) * DM + u.pn * 256 + wc * 32 + 8 * fq;
                f32x4 hv[2][2][2];
                float ra[2] = {1.f, 1.f};
                if (I8_P6) { ra[0] = sa[(size_t)u.pm * 256 + rr]; ra[1] = sa[(size_t)u.pm * 256 + rr + 16]; }
                if (hsrc) {
#pragma unroll
                    for (int mm = 0; mm < 2; ++mm)
#pragma unroll
                        for (int bj = 0; bj < 2; ++bj) { const size_t o = o0 + (size_t)mm * 16 * DM + bj * 128; hv[mm][bj][0] = *(const f32x4*)(hsrc + o); hv[mm][bj][1] = *(const f32x4*)(hsrc + o + 4); }
                } else { u32x4 hq[2][2];
#pragma unroll
                    for (int mm = 0; mm < 2; ++mm)
#pragma unroll
                        for (int bj = 0; bj < 2; ++bj) hq[mm][bj] = *(const u32x4*)(hsb + o0 + (size_t)mm * 16 * DM + bj * 128);
#pragma unroll
                    for (int mm = 0; mm < 2; ++mm)
#pragma unroll
                        for (int bj = 0; bj < 2; ++bj) { const u32x4 q = hq[mm][bj]; hv[mm][bj][0] = (f32x4){bf_lo(q.x), bf_hi(q.x), bf_lo(q.y), bf_hi(q.y)}; hv[mm][bj][1] = (f32x4){bf_lo(q.z), bf_hi(q.z), bf_lo(q.w), bf_hi(q.w)}; } }
#pragma unroll
                for (int mm = 0; mm < 2; ++mm)
#pragma unroll
                    for (int bj = 0; bj < 2; ++bj) { const int m = mp * 2 + mm; const size_t o = o0 + (size_t)mm * 16 * DM + bj * 128;
                        f32x4 d0 = acc[ai][bj][m][0], d1 = acc[ai][bj][m][1];
                        if (I8_P6) {
#pragma unroll
                            for (int i = 0; i < 4; ++i) { d0[i] = (float)__float_as_int(d0[i]) * ra[mm] * cs[bj][0][i]; d1[i] = (float)__float_as_int(d1[i]) * ra[mm] * cs[bj][1][i]; } }
                        const f32x4 v0 = hv[mm][bj][0] + d0, v1 = hv[mm][bj][1] + d1;
                        u32x4 w; w.x = cvt_pk_bf16(v0[0], v0[1]); w.y = cvt_pk_bf16(v0[2], v0[3]); w.z = cvt_pk_bf16(v1[0], v1[1]); w.w = cvt_pk_bf16(v1[2], v1[3]);
                        *(u32x4*)(hb + o) = w; }
                asm volatile("" ::: "memory"); }
        pg8::zero_acc(acc);
    }
};
struct EpiGate {
    static constexpr bool AFTER_DRAIN = false;
    const bf16* hin; float* dst; const bf16* er; const float* rse; const float* pg; bf16* hb; float* PS; LAS float* red; const float* sa; const float* sg;
    __device__ __forceinline__ void operator()(pg8::Acc& acc, const pg8::Unit& u, int wr, int wc, int fr, int fq) const {
        const int col0 = u.pn * 256 + wc * 32 + 8 * fq;
        f32x4 g[2][2];
#pragma unroll
        for (int bj = 0; bj < 2; ++bj) { g[bj][0] = *(const f32x4*)(pg + col0 + bj * 128); g[bj][1] = *(const f32x4*)(pg + col0 + bj * 128 + 4); }
        f32x4 cs[2][2];
#pragma unroll
        for (int bj = 0; bj < 2; ++bj) { if (I8_P7) { cs[bj][0] = *(const f32x4*)(sg + col0 + bj * 128) * -1.4426950408889634f; cs[bj][1] = *(const f32x4*)(sg + col0 + bj * 128 + 4) * -1.4426950408889634f; }
            else { cs[bj][0] = (f32x4){-1.4426950408889634f, -1.4426950408889634f, -1.4426950408889634f, -1.4426950408889634f}; cs[bj][1] = cs[bj][0]; } }
#pragma unroll
        for (int ai = 0; ai < 2; ++ai)
#pragma unroll
            for (int mp = 0; mp < 2; ++mp) {
                int rr = ai * 128 + wr * 64 + mp * 32 + fr; asm volatile("" : "+v"(rr));
                const size_t row0 = (size_t)u.pm * 256 + rr, o0 = row0 * DM + col0;
                u32x4 hq[2][2]; u32x4 ev[2][2]; float rs[2], ra[2];
#pragma unroll
                for (int mm = 0; mm < 2; ++mm) { const float* pp = rse + (row0 + mm * 16) * 8; const f32x4 q0 = *(const f32x4*)pp, q1 = *(const f32x4*)(pp + 4);
                    ra[mm] = I8_P7 ? sa[row0 + mm * 16] : 1.0f;
                    rs[mm] = 1.0f / sqrtf((((q0.x + q0.y) + (q0.z + q0.w)) + ((q1.x + q1.y) + (q1.z + q1.w))) * (1.f / DM) + EPS);
#pragma unroll
                    for (int bj = 0; bj < 2; ++bj) { const size_t o = o0 + (size_t)mm * 16 * DM + bj * 128; hq[mm][bj] = *(const u32x4*)(hin + o); ev[mm][bj] = *(const u32x4*)(er + o); } }
#pragma unroll
                for (int mm = 0; mm < 2; ++mm) { float ssq = 0.f;
#pragma unroll
                    for (int bj = 0; bj < 2; ++bj) { const int m = mp * 2 + mm; const size_t o = o0 + (size_t)mm * 16 * DM + bj * 128; const u32x4 e = ev[mm][bj], q = hq[mm][bj];
                        const f32x4 e0 = (f32x4){bf_lo(e.x), bf_hi(e.x), bf_lo(e.y), bf_hi(e.y)} * g[bj][0] * rs[mm], e1 = (f32x4){bf_lo(e.z), bf_hi(e.z), bf_lo(e.w), bf_hi(e.w)} * g[bj][1] * rs[mm];
                        f32x4 a0 = acc[ai][bj][m][0], a1 = acc[ai][bj][m][1];
#pragma unroll
                        for (int i = 0; i < 4; ++i) { if (I8_P7) { a0[i] = (float)__float_as_int(a0[i]) * ra[mm]; a1[i] = (float)__float_as_int(a1[i]) * ra[mm]; }
                            a0[i] = __builtin_amdgcn_rcpf(1.0f + __builtin_amdgcn_exp2f(cs[bj][0][i] * a0[i])); a1[i] = __builtin_amdgcn_rcpf(1.0f + __builtin_amdgcn_exp2f(cs[bj][1][i] * a1[i])); }
                        const f32x4 v0 = (f32x4){bf_lo(q.x), bf_hi(q.x), bf_lo(q.y), bf_hi(q.y)} + a0 * e0, v1 = (f32x4){bf_lo(q.z), bf_hi(q.z), bf_lo(q.w), bf_hi(q.w)} + a1 * e1;
                        if (dst) { *(f32x4*)(dst + o) = v0; *(f32x4*)(dst + o + 4) = v1; }
                        u32x4 w; w.x = cvt_pk_bf16(v0[0], v0[1]); w.y = cvt_pk_bf16(v0[2], v0[3]); w.z = cvt_pk_bf16(v1[0], v1[1]); w.w = cvt_pk_bf16(v1[2], v1[3]);
                        if (hb) *(u32x4*)(hb + o) = w;
                        ssq += ((v0.x * v0.x + v0.y * v0.y) + (v0.z * v0.z + v0.w * v0.w)) + ((v1.x * v1.x + v1.y * v1.y) + (v1.z * v1.z + v1.w * v1.w)); }
                    ssq += xlane<16>(ssq); ssq = xsum32(ssq);
                    if (fq == 0) red[(rr + mm * 16) * 4 + wc] = ssq; }
                asm volatile("" ::: "memory"); }
        LDS_WAIT(); __builtin_amdgcn_s_barrier(); asm volatile("" ::: "memory");
        { const int t2 = (wr * 4 + wc) * 64 + fq * 16 + fr;
          if (t2 < 256) { const f32x4 r4 = *(const LAS f32x4*)(red + t2 * 4); PS[((size_t)u.pm * 256 + t2) * 8 + u.pn] = (r4.x + r4.y) + (r4.z + r4.w); } }
        LDS_WAIT(); __builtin_amdgcn_s_barrier(); asm volatile("" ::: "memory");
        pg8::zero_acc(acc);
    }
};

constexpr int LRU_SEGC = 4, LRU_NSEG = 64 / LRU_SEGC, LRU_UNITS = NBATCH * LRU_NSEG * 8;
template <int PASS>
__device__ __forceinline__ void lru_unit(const Frame& F, int tid, int lane, int l, int unit, const bf16* gw, bool dummy = false) {
    typedef float f32x16 __attribute__((ext_vector_type(16)));
    const int cg = unit & 7, seg = (unit >> 3) & (LRU_NSEG - 1), b = unit / (8 * LRU_NSEG), ch0 = cg * 128;
    LAS float* ucf = (LAS float*)F.lds;
    LAS bf16* ucb = (LAS bf16*)(F.lds + 32768);
    LAS float* tot = (LAS float*)(F.lds + 32768 + 17408);
    float* SUMA = (float*)(F.ws + WS_LRUS); float* SUMD = SUMA + NBATCH * LRU_NSEG * BW;
    constexpr int UP = 136;
    const int wid = F.wave, tt = wid & 1, jt = wid >> 1, blk = jt >> 1, j0 = (jt & 1) * 32, r32 = lane & 31, hi = lane >> 5;
    const int co = tid & 15, tk0 = tid >> 4, chc = ch0 + co * 8;
    const int chl = jt * 32 + r32, ch = ch0 + chl;
    float cw[4][8], cb[8];
#pragma unroll
    for (int q = 0; q < 4; ++q) { const f32x4 a = *(const f32x4*)(INP(I_CONVW) + ((size_t)l * 4 + q) * BW + chc), c = *(const f32x4*)(INP(I_CONVW) + ((size_t)l * 4 + q) * BW + chc + 4);
        cw[q][0] = a.x; cw[q][1] = a.y; cw[q][2] = a.z; cw[q][3] = a.w; cw[q][4] = c.x; cw[q][5] = c.y; cw[q][6] = c.z; cw[q][7] = c.w; }
    { const f32x4 a = *(const f32x4*)(INP(I_CONVB) + (size_t)l * BW + chc), c = *(const f32x4*)(INP(I_CONVB) + (size_t)l * BW + chc + 4);
      cb[0] = a.x; cb[1] = a.y; cb[2] = a.z; cb[3] = a.w; cb[4] = c.x; cb[5] = c.y; cb[6] = c.z; cb[7] = c.w; }
    bf16x8 fwa[4], fwx[4];
    { const bf16* wa = gw + ((size_t)(cg * 2 + blk) * 64 + j0 + r32) * 64 + hi * 8;
#pragma unroll
      for (int ks = 0; ks < 4; ++ks) { fwa[ks] = *(const bf16x8*)(wa + ks * 16); fwx[ks] = *(const bf16x8*)(wa + 16 * 4096 + ks * 16); } }
    const float ba = INP(I_BA)[(size_t)l * BW + ch], bx = INP(I_BX)[(size_t)l * BW + ch], lam = INP(I_LAM)[(size_t)l * BW + ch];
    const float sp8 = -8.0f * 1.4426950408889634f * ((-lam > 20.f) ? -lam : log1pf(__expf(-lam)));
    const bf16* U = ZP(Z_U) + chc;
    u32x4 up[2][4];
    u32x4 gpre[2] = {{0u, 0u, 0u, 0u}, {0u, 0u, 0u, 0u}};
#define LRU_LOADU(tch_) do { _Pragma("unroll") for (int i_ = 0; i_ < 2; ++i_) { const int sq_ = (tch_) * 64 + tk0 + 32 * i_; _Pragma("unroll") for (int q_ = 0; q_ < 4; ++q_) \
        up[i_][q_] = (sq_ - 3 + q_ >= 0) ? *(const u32x4*)(U + ((size_t)b * SEQ + sq_ - 3 + q_) * BW) : (u32x4){0u, 0u, 0u, 0u}; } } while (0)
#define LRU_LOADG(tch_, dst) do { if (PASS == 2) { _Pragma("unroll") for (int i_ = 0; i_ < 2; ++i_) dst[i_] = *(const u32x4*)(ZP(Z_GA) + ((size_t)b * SEQ + (tch_) * 64 + tk0 + 32 * i_) * BW + chc); } } while (0)
    LRU_LOADU(seg * LRU_SEGC); LRU_LOADG(seg * LRU_SEGC, gpre);
    float sA = 1.f, sD = 0.f, h = 0.f;
    if (PASS == 2) { const float* sa = SUMA + (size_t)b * LRU_NSEG * BW + ch; const float* sd = SUMD + (size_t)b * LRU_NSEG * BW + ch;
        float fa[LRU_NSEG - 1], fd[LRU_NSEG - 1];
#pragma unroll
        for (int c = 0; c < LRU_NSEG - 1; ++c) { const bool on = c < seg; fa[c] = on ? sa[(size_t)c * BW] : 1.f; fd[c] = on ? sd[(size_t)c * BW] : 0.f; }
#pragma unroll
        for (int c = 0; c < LRU_NSEG - 1; ++c) h = fa[c] * h + fd[c]; }
    for (int ci = 0; ci < LRU_SEGC; ++ci) {
        const int tch = seg * LRU_SEGC + ci, t0 = tch * 64;
        __syncthreads();
#pragma unroll
        for (int i = 0; i < 2; ++i) { const int tk = tk0 + 32 * i;
            float uc[8];
#pragma unroll
            for (int e = 0; e < 8; ++e) uc[e] = cb[e];
#pragma unroll
            for (int q = 0; q < 4; ++q) { const u32x4 w = up[i][q];
                uc[0] += cw[q][0] * bf_lo(w.x); uc[1] += cw[q][1] * bf_hi(w.x); uc[2] += cw[q][2] * bf_lo(w.y); uc[3] += cw[q][3] * bf_hi(w.y);
                uc[4] += cw[q][4] * bf_lo(w.z); uc[5] += cw[q][5] * bf_hi(w.z); uc[6] += cw[q][6] * bf_lo(w.w); uc[7] += cw[q][7] * bf_hi(w.w); }
            *(LAS f32x4*)(ucf + tk * 128 + co * 8) = (f32x4){uc[0], uc[1], uc[2], uc[3]}; *(LAS f32x4*)(ucf + tk * 128 + co * 8 + 4) = (f32x4){uc[4], uc[5], uc[6], uc[7]};
            u32x4 p; p.x = cvt_pk_bf16(uc[0], uc[1]); p.y = cvt_pk_bf16(uc[2], uc[3]); p.z = cvt_pk_bf16(uc[4], uc[5]); p.w = cvt_pk_bf16(uc[6], uc[7]);
            *(LAS u32x4*)(ucb + tk * UP + co * 8) = p; }
        u32x4 gcur[2] = {gpre[0], gpre[1]};
        if (ci + 1 < LRU_SEGC) { LRU_LOADU(tch + 1); LRU_LOADG(tch + 1, gpre); }
        __syncthreads();
        f32x16 ar = {}, ax = {};
#pragma unroll
        for (int ks = 0; ks < 4; ++ks) {
            const bf16x8 af = *(const LAS bf16x8*)(ucb + (tt * 32 + r32) * UP + blk * 64 + ks * 16 + hi * 8);
            ar = __builtin_amdgcn_mfma_f32_32x32x16_bf16(af, fwa[ks], ar, 0, 0, 0);
            ax = __builtin_amdgcn_mfma_f32_32x32x16_bf16(af, fwx[ks], ax, 0, 0, 0);
        }
#pragma unroll
        for (int r = 0; r < 16; ++r) { const int tk = tt * 32 + (r & 3) + 8 * (r >> 2) + 4 * hi;
            constexpr float L2E = 1.4426950408889634f;
            const float rec = __builtin_amdgcn_rcpf(1.0f + __builtin_amdgcn_exp2f(-L2E * (ar[r] + ba))), inp = __builtin_amdgcn_rcpf(1.0f + __builtin_amdgcn_exp2f(-L2E * (ax[r] + bx)));
            const float a = __builtin_amdgcn_exp2f(rec * sp8);
            ar[r] = a; ax[r] = __builtin_amdgcn_sqrtf(fmaf(-a, a, 1.0f)) * (inp * ucf[tk * 128 + chl]); }
        float gA[4], gD[4];
#pragma unroll
        for (int g = 0; g < 4; ++g) { gA[g] = ar[4 * g]; gD[g] = ax[4 * g];
#pragma unroll
            for (int i = 1; i < 4; ++i) { gD[g] = gD[g] * ar[4 * g + i] + ax[4 * g + i]; gA[g] *= ar[4 * g + i]; } }
        float pA[4], pD[4], TA = 1.f, TD = 0.f;
#pragma unroll
        for (int g = 0; g < 4; ++g) {
            const auto ra = __builtin_amdgcn_permlane32_swap(__float_as_uint(gA[g]), __float_as_uint(gA[g]), false, false);
            const auto rd = __builtin_amdgcn_permlane32_swap(__float_as_uint(gD[g]), __float_as_uint(gD[g]), false, false);
            const float a0 = __uint_as_float(ra[0]), a1 = __uint_as_float(ra[1]), d0 = __uint_as_float(rd[0]), d1 = __uint_as_float(rd[1]);
            const float midA = TA * a0, midD = TD * a0 + d0;
            pA[g] = hi ? midA : TA; pD[g] = hi ? midD : TD;
            TA = midA * a1; TD = midD * a1 + d1; }
        if (hi == 0) { tot[(wid * 2 + 0) * 32 + r32] = TA; tot[(wid * 2 + 1) * 32 + r32] = TD; }
        __syncthreads();
        const float A0 = tot[((wid & ~1) * 2 + 0) * 32 + r32], D0 = tot[((wid & ~1) * 2 + 1) * 32 + r32];
        const float A1 = tot[((wid | 1) * 2 + 0) * 32 + r32], D1 = tot[((wid | 1) * 2 + 1) * 32 + r32];
        const float CA = A0 * A1, CD = D0 * A1 + D1;
        if (PASS == 1) { sD = sD * CA + CD; sA *= CA; }
        else {
            const float hin = tt ? A0 * h + D0 : h;
#pragma unroll
            for (int g = 0; g < 4; ++g) { float hg = pA[g] * hin + pD[g];
#pragma unroll
                for (int i = 0; i < 4; ++i) { hg = ar[4 * g + i] * hg + ax[4 * g + i]; ucf[(tt * 32 + 8 * g + 4 * hi + i) * 128 + chl] = hg; } }
            h = CA * h + CD;
            __syncthreads();
#pragma unroll
            for (int i = 0; i < 2; ++i) { const int tk = tk0 + 32 * i; const size_t o = ((size_t)b * SEQ + t0 + tk) * BW + chc;
                const f32x4 h0 = *(const LAS f32x4*)(ucf + tk * 128 + co * 8), h1 = *(const LAS f32x4*)(ucf + tk * 128 + co * 8 + 4);
                const u32x4 gt = gcur[i]; u32x4 y;
                y.x = cvt_pk_bf16(h0.x * bf_lo(gt.x), h0.y * bf_hi(gt.x)); y.y = cvt_pk_bf16(h0.z * bf_lo(gt.y), h0.w * bf_hi(gt.y));
                y.z = cvt_pk_bf16(h1.x * bf_lo(gt.z), h1.y * bf_hi(gt.z)); y.w = cvt_pk_bf16(h1.z * bf_lo(gt.w), h1.w * bf_hi(gt.w));
                *(u32x4*)((dummy ? (bf16*)(F.ws + WS_X1) : ZP(Z_GA)) + o) = y; }
        }
    }
#undef LRU_LOADU
#undef LRU_LOADG
    if (PASS == 1) { if (tt == 0 && hi == 0) { const size_t o = ((size_t)b * LRU_NSEG + seg) * BW + ch; SUMA[o] = sA; SUMD[o] = sD; } }
}
__device__ __forceinline__ void fox_cumsum_item(const Frame& F, int lane, int item) {
    const int b = item >> 3, h = item & 7; const float* LF = (const float*)(F.ws + WS_Z + Z_LF); float* CF = (float*)(F.ws + WS_Z + Z_CF);
    const size_t r0 = (size_t)b * SEQ + lane * 64;
    float s = 0.f;
    for (int t = 0; t < 64; ++t) s += LF[(r0 + t) * 8 + h];
    float inc = s;
#pragma unroll
    for (int o = 1; o < 64; o <<= 1) { const float v = __int_as_float(__builtin_amdgcn_ds_bpermute((lane - o) << 2, __float_as_int(inc))); if (lane >= o) inc += v; }
    float run = inc - s;
    for (int t = 0; t < 64; ++t) { run += LF[(r0 + t) * 8 + h]; CF[((size_t)b * 8 + h) * SEQ + lane * 64 + t] = run * (-1.0f / SCALE); }
}
__device__ __forceinline__ void phase_erstd(const Frame& F0) {
    const Frame F = pin(F0); PHASE_IDS();
    const bf16* er = (const bf16*)(F.ws + WS_X1); float* rse = (float*)(F.ws + WS_RSE);
    const int gw = F.vcu * NWAVES + F.wave, NGW = F.G * NWAVES;
    for (int m = gw; m < T; m += NGW) { const u32x4* r = (const u32x4*)(er + (size_t)m * DM) + lane; float s = 0.f;
#pragma unroll
        for (int q = 0; q < 4; ++q) { const u32x4 w = r[64 * q]; float a;
            a = bf_lo(w.x); s += a * a; a = bf_hi(w.x); s += a * a; a = bf_lo(w.y); s += a * a; a = bf_hi(w.y); s += a * a;
            a = bf_lo(w.z); s += a * a; a = bf_hi(w.z); s += a * a; a = bf_lo(w.w); s += a * a; a = bf_hi(w.w); s += a * a; }
        s = wave_sum(s); if (lane == 0) rse[m] = 1.0f / sqrtf(s * (1.f / DM) + EPS); }
}

namespace att {
typedef short s16x4 __attribute__((ext_vector_type(4)));
typedef float f32x16 __attribute__((ext_vector_type(16)));
constexpr int KVBLK = 64, SHM_V = 16384, SHM_K = 16384;
constexpr float THR = 8.f;
#define KSWZ(row, colB) ((row) * 256 + ((colB) ^ (((row) & 7) << 4)))
#define SBAR() __builtin_amdgcn_sched_barrier(0)
__device__ __forceinline__ int v_st(int k, int c) { const int kk = (k & ~0xC) | ((k & 4) << 1) | ((k & 8) >> 1); return ((kk >> 3) * 4 + (c >> 5)) * 512 + ((kk & 7) * 32 + (c & 31)) * 2; }
__device__ __forceinline__ int v_rd_base(int lane) { return ((lane & 3) << 3) | (((lane >> 2) & 3) << 6) | (((lane >> 4) & 1) << 5) | (((lane >> 5) & 1) << 8); }
constexpr int v_rd_off(int d0, int ks, int half) { return d0 * 512 + ks * 4096 + half * 2048; }
__device__ __forceinline__ int crow(int r, int hi) { return (r & 3) + 8 * (r >> 2) + 4 * hi; }
__device__ __forceinline__ void mask_tile(f32x16& p0, f32x16& p1, int dq, unsigned W) {
    const float NEG = -__builtin_inff();
#pragma unroll
    for (int r = 0; r < 16; ++r) {
        const int c = (r & 3) + 8 * (r >> 2);
        if ((unsigned)(dq - c) >= W) p0[r] = NEG;
        if ((unsigned)(dq - c - 32) >= W) p1[r] = NEG;
    }
}
template <bool GATED = false>
__device__ __forceinline__ void partialSM(f32x16& p0, f32x16& p1, float& m_reg, float& mn, float& alpha, bool lane_on = true) {
    float pmax = p0[0];
#pragma unroll
    for (int r = 1; r < 16; ++r) pmax = fmaxf(pmax, p0[r]);
#pragma unroll
    for (int r = 0; r < 16; ++r) pmax = fmaxf(pmax, p1[r]);
    { auto rr = __builtin_amdgcn_permlane32_swap(__float_as_uint(pmax), __float_as_uint(pmax), false, false);
      pmax = fmaxf(__uint_as_float(rr[0]), __uint_as_float(rr[1])); }
    constexpr float C2 = 1.4426950408889634f * SCALE;
    if (GATED) { if (!lane_on) pmax = -__builtin_inff(); }
    if (__builtin_expect(__all((pmax - m_reg) * SCALE <= THR), 1)) { mn = m_reg; alpha = 1.f; }
    else { mn = fmaxf(m_reg, pmax); alpha = __builtin_amdgcn_exp2f((m_reg - mn) * C2); m_reg = mn; }
    float mnL = -mn * C2;
    if (GATED) { if (!lane_on) mnL = -__builtin_inff(); }
#pragma unroll
    for (int r = 0; r < 16; ++r) p0[r] = fmaf(p0[r], C2, mnL);
#pragma unroll
    for (int r = 0; r < 16; ++r) p1[r] = fmaf(p1[r], C2, mnL);
#pragma unroll
    for (int r = 0; r < 16; ++r) p0[r] = __builtin_amdgcn_exp2f(p0[r]);
}
#define PK4(P, B_, OUT) do { unsigned a0 = cvt_pk_bf16(P[B_+0], P[B_+1]), a1 = cvt_pk_bf16(P[B_+2], P[B_+3]);                          \
        unsigned b0 = cvt_pk_bf16(P[B_+4], P[B_+5]), b1 = cvt_pk_bf16(P[B_+6], P[B_+7]);                                             \
        auto r0 = __builtin_amdgcn_permlane32_swap(a0, b0, false, false); auto r1 = __builtin_amdgcn_permlane32_swap(a1, b1, false, false); \
        u32x4 w = {r0[0], r1[0], r0[1], r1[1]}; OUT = *reinterpret_cast<bf16x8*>(&w); } while (0)
__device__ __forceinline__ void finishSM(f32x16& p0, f32x16& p1, float alpha, float& l_reg, bf16x8& pa0, bf16x8& pa1, bf16x8& pa2, bf16x8& pa3) {
#pragma unroll
    for (int r = 0; r < 16; ++r) p1[r] = __builtin_amdgcn_exp2f(p1[r]);
    float ps = 0;
#pragma unroll
    for (int r = 0; r < 16; ++r) ps += p0[r];
#pragma unroll
    for (int r = 0; r < 16; ++r) ps += p1[r];
    ps = xsum32(ps);
    l_reg = l_reg * alpha + ps;
    PK4(p0, 0, pa0); PK4(p0, 8, pa1); PK4(p1, 0, pa2); PK4(p1, 8, pa3);
}
__device__ __forceinline__ void qkt(f32x16& p0, f32x16& p1, const LAS char* kt, int r32, int hi, const bf16x8* qr) {
    p0 = f32x16{}; p1 = f32x16{};
    const LAS char* kb[4];
#pragma unroll
    for (int dd = 0; dd < 4; ++dd) kb[dd] = kt + KSWZ(r32, (dd * 16 + hi * 8) * 2);
#pragma unroll
    for (int d0 = 0; d0 < 8; ++d0) { const LAS char* a = kb[d0 & 3] + (d0 >> 2) * 128;
        bf16x8 b0 = *reinterpret_cast<const LAS bf16x8*>(a);
        bf16x8 b1 = *reinterpret_cast<const LAS bf16x8*>(a + 32 * 256);
        p0 = __builtin_amdgcn_mfma_f32_32x32x16_bf16(b0, qr[d0], p0, 0, 0, 0);
        p1 = __builtin_amdgcn_mfma_f32_32x32x16_bf16(b1, qr[d0], p1, 0, 0, 0); }
}
template <int VOFF>
__device__ __forceinline__ void pv_tile(f32x16* o, int vb0, bf16x8 pa0, bf16x8 pa1, bf16x8 pa2, bf16x8 pa3) {
#define TRRD(dst, off) asm volatile("ds_read_b64_tr_b16 %0, %1 offset:%2" : "=&v"(dst) : "v"(vb0), "i"(off) : "memory")
#define PV_D0(d0) do { s16x4 l0, l1, l2, l3, h0, h1, h2, h3; constexpr int b_ = VOFF + v_rd_off(d0, 0, 0); \
        TRRD(l0, b_); TRRD(h0, b_ + 2048); TRRD(l1, b_ + 4096); TRRD(h1, b_ + 6144); TRRD(l2, b_ + 8192); TRRD(h2, b_ + 10240); TRRD(l3, b_ + 12288); TRRD(h3, b_ + 14336); \
        asm volatile("s_waitcnt lgkmcnt(0)" ::: "memory"); SBAR();   \
        o[d0] = __builtin_amdgcn_mfma_f32_32x32x16_bf16(pa0, (bf16x8){l0[0], l0[1], l0[2], l0[3], h0[0], h0[1], h0[2], h0[3]}, o[d0], 0, 0, 0);   \
        o[d0] = __builtin_amdgcn_mfma_f32_32x32x16_bf16(pa1, (bf16x8){l1[0], l1[1], l1[2], l1[3], h1[0], h1[1], h1[2], h1[3]}, o[d0], 0, 0, 0);   \
        o[d0] = __builtin_amdgcn_mfma_f32_32x32x16_bf16(pa2, (bf16x8){l2[0], l2[1], l2[2], l2[3], h2[0], h2[1], h2[2], h2[3]}, o[d0], 0, 0, 0);   \
        o[d0] = __builtin_amdgcn_mfma_f32_32x32x16_bf16(pa3, (bf16x8){l3[0], l3[1], l3[2], l3[3], h3[0], h3[1], h3[2], h3[3]}, o[d0], 0, 0, 0); } while (0)
    PV_D0(0); PV_D0(1); PV_D0(2); PV_D0(3);
#undef PV_D0
#undef TRRD
}

typedef float f32x2 __attribute__((ext_vector_type(2)));
#define MF32(a_, b_, c_) __builtin_amdgcn_mfma_f32_32x32x16_bf16(a_, b_, c_, 0, 0, 0)
#define MAX8(P0_, P1_, j) fmaxf(fmaxf(fmaxf(fmaxf(fmaxf(fmaxf(fmaxf(P0_[4 * (j)], P0_[4 * (j) + 1]), P0_[4 * (j) + 2]), P0_[4 * (j) + 3]), P1_[4 * (j)]), P1_[4 * (j) + 1]), P1_[4 * (j) + 2]), P1_[4 * (j) + 3])
#define PIN(x) asm volatile("" : "+v"(x))
template <bool FOXB>
__device__ __forceinline__ void qkt_fin(f32x16& x0, f32x16& x1, const LAS char* kt, int r32, int hi, const bf16x8* qr, const LAS float* cbp,
                                        f32x16& y0, f32x16& y1, float alpha, float& l_reg, bf16x8& pa0, bf16x8& pa1, bf16x8& pa2, bf16x8& pa3) {
    const LAS char* kb[4];
#pragma unroll
    for (int dd = 0; dd < 4; ++dd) kb[dd] = kt + KSWZ(r32, (dd * 16 + hi * 8) * 2);
#define KRD(k) (*reinterpret_cast<const LAS bf16x8*>(kb[((k) >> 1) & 3] + ((k) >> 3) * 128 + ((k) & 1) * (32 * 256)))
    bf16x8 kf[16];
    kf[0] = KRD(0); kf[1] = KRD(1); kf[2] = KRD(2); kf[3] = KRD(3);
    if (FOXB) {
#pragma unroll
        for (int g_ = 0; g_ < 4; ++g_) { const f32x4 c0 = *(const LAS f32x4*)(cbp + 8 * g_), c1 = *(const LAS f32x4*)(cbp + 32 + 8 * g_);
#pragma unroll
            for (int i_ = 0; i_ < 4; ++i_) { x0[4 * g_ + i_] = c0[i_]; x1[4 * g_ + i_] = c1[i_]; } }
    } else { x0 = f32x16{}; x1 = f32x16{}; }
    SBAR();
    f32x2 a0, a1, a2, a3, b0, b1; float s0 = 0.f, s1 = 0.f;
#define QS(k, VALU_) do { if ((k) + 4 < 16) kf[((k) + 4) & 15] = KRD(((k) + 4) & 15); \
        if ((k) & 1) x1 = MF32(kf[k], qr[(k) >> 1], x1); else x0 = MF32(kf[k], qr[(k) >> 1], x0); VALU_; SBAR(); } while (0)
#define EX2(j) do { y1[2 * (j)] = __builtin_amdgcn_exp2f(y1[2 * (j)]); y1[2 * (j) + 1] = __builtin_amdgcn_exp2f(y1[2 * (j) + 1]); } while (0)
#define PKS(Y_, j) ((f32x2){Y_[4 * (j)], Y_[4 * (j) + 1]} + (f32x2){Y_[4 * (j) + 2], Y_[4 * (j) + 3]})
    QS(0, EX2(0); a0 = PKS(y0, 0); PIN(y1); PIN(a0));
    QS(1, EX2(1); a1 = PKS(y0, 1); PIN(y1); PIN(a1));
    QS(2, EX2(2); a2 = PKS(y0, 2); PIN(y1); PIN(a2));
    QS(3, EX2(3); a3 = PKS(y0, 3); PIN(y1); PIN(a3));
    QS(4, EX2(4); b0 = a0 + a1; PIN(y1); PIN(b0));
    QS(5, EX2(5); b1 = a2 + a3; PIN(y1); PIN(b1));
    QS(6, EX2(6); b0 = b0 + b1; PIN(y1); PIN(b0));
    QS(7, EX2(7); s0 = b0.x + b0.y; PIN(y1); PIN(s0));
    QS(8, a0 = PKS(y1, 0); a1 = PKS(y1, 1); PK4(y0, 0, pa0); PIN(a0); PIN(a1); PIN(pa0));
    QS(9, a2 = PKS(y1, 2); a3 = PKS(y1, 3); PK4(y0, 8, pa1); PIN(a2); PIN(a3); PIN(pa1));
    QS(10, b0 = a0 + a1; b1 = a2 + a3; b0 = b0 + b1; s1 = b0.x + b0.y; PIN(s1));
    QS(11, { float ps = xsum32(s0 + s1); l_reg = l_reg * alpha + ps; PIN(l_reg); });
    QS(12, PK4(y1, 0, pa2); PIN(pa2));
    QS(13, PK4(y1, 8, pa3); PIN(pa3));
    QS(14, );
    QS(15, );
#undef QS
#undef EX2
#undef PKS
#undef KRD
}
template <int VOFF, bool GATED>
__device__ __forceinline__ void pv_psm(f32x16 (&o)[4], const LAS char* vb, bf16x8 pa0, bf16x8 pa1, bf16x8 pa2, bf16x8 pa3,
                                       f32x16& p0, f32x16& p1, float& m_reg, float& mn, float& alpha, bool lane_on) {
    constexpr float C2 = 1.4426950408889634f * SCALE;
#define VFR(k) ({ const s16x4 l_ = __builtin_amdgcn_ds_read_tr16_b64_v4i16((LAS s16x4*)(vb + VOFF + v_rd_off((k) & 3, 0, 0) + 4096 * ((k) >> 2))); \
                  const s16x4 h_ = __builtin_amdgcn_ds_read_tr16_b64_v4i16((LAS s16x4*)(vb + VOFF + v_rd_off((k) & 3, 0, 0) + 4096 * ((k) >> 2) + 2048)); \
                  (bf16x8){l_[0], l_[1], l_[2], l_[3], h_[0], h_[1], h_[2], h_[3]}; })
    bf16x8 vf[16];
    vf[0] = VFR(0); vf[1] = VFR(1); vf[2] = VFR(2);
    SBAR();
    float q0, q1, q2, q3, mnL = 0.f;
#define PS(k, VALU_) do { if ((k) + 3 < 16) vf[((k) + 3) & 15] = VFR(((k) + 3) & 15); \
        o[(k) & 3] = MF32((k) < 4 ? pa0 : (k) < 8 ? pa1 : (k) < 12 ? pa2 : pa3, vf[k], o[(k) & 3]); VALU_; SBAR(); } while (0)
#define FM8(P_, j) do { _Pragma("unroll") for (int r_ = 8 * (j); r_ < 8 * (j) + 8; ++r_) P_[r_] = fmaf(P_[r_], C2, mnL); } while (0)
#define EP2(j) do { p0[2 * (j)] = __builtin_amdgcn_exp2f(p0[2 * (j)]); p0[2 * (j) + 1] = __builtin_amdgcn_exp2f(p0[2 * (j) + 1]); } while (0)
    PS(0, q0 = MAX8(p0, p1, 0); PIN(q0));
    PS(1, q1 = MAX8(p0, p1, 1); PIN(q1));
    PS(2, q2 = MAX8(p0, p1, 2); PIN(q2));
    PS(3, q3 = MAX8(p0, p1, 3); PIN(q3));
    PS(4, { float pmax = fmaxf(fmaxf(q0, q1), fmaxf(q2, q3));
            { auto rr = __builtin_amdgcn_permlane32_swap(__float_as_uint(pmax), __float_as_uint(pmax), false, false); pmax = fmaxf(__uint_as_float(rr[0]), __uint_as_float(rr[1])); }
            if (GATED) pmax = lane_on ? pmax : -__builtin_inff();
            const bool keep = __all((pmax - m_reg) * SCALE <= THR);
            mn = keep ? m_reg : fmaxf(m_reg, pmax); alpha = __builtin_amdgcn_exp2f((m_reg - mn) * C2); m_reg = mn;
            mnL = -mn * C2; if (GATED) mnL = lane_on ? mnL : -__builtin_inff(); PIN(mnL); PIN(alpha); PIN(m_reg); });
    PS(5, FM8(p0, 0); PIN(p0));
    PS(6, FM8(p0, 1); PIN(p0));
    PS(7, FM8(p1, 0); EP2(0); PIN(p0); PIN(p1));
    PS(8, FM8(p1, 1); EP2(1); PIN(p0); PIN(p1));
    PS(9, EP2(2); PIN(p0));
    PS(10, EP2(3); PIN(p0));
    PS(11, EP2(4); PIN(p0));
    PS(12, EP2(5); PIN(p0));
    PS(13, EP2(6); PIN(p0));
    PS(14, EP2(7); PIN(p0));
    PS(15, );
#undef PS
#undef FM8
#undef EP2
#undef VFR
}
enum { M_FOX = 0, M_SEL = 1, M_WIN = 2 };
constexpr int STREAM_LDS = 2 * SHM_V + 2 * SHM_K + 512 + 8 * 256;
#define ATT_PRELOAD(Kh_, Vh_, k0_, tid_, pk0_, pk1_, pv0_, pv1_) do { const int sr_ = (tid_) >> 4, sc_ = ((tid_) & 15) * 8; \
        pv0_ = *(const bf16x8*)((Vh_) + (size_t)((k0_) + sr_) * HD + sc_); pv1_ = *(const bf16x8*)((Vh_) + (size_t)((k0_) + 32 + sr_) * HD + sc_); \
        pk0_ = *(const bf16x8*)((Kh_) + (size_t)((k0_) + sr_) * HD + sc_); pk1_ = *(const bf16x8*)((Kh_) + (size_t)((k0_) + 32 + sr_) * HD + sc_); } while (0)
template <int MODE, bool CONT = false, bool PRE = false, bool DESC = false>
__device__ __forceinline__ void attn_stream(LAS char* lds, int tid, int wid, int lane, const bf16x8 (&qr)[8], const bf16* Kh, const bf16* Vh, const float* cb,
                                            int j_lo, int NT, int qpos, int qlo, int qhi, unsigned selLo, unsigned selHi, f32x16 (&o)[4], float& m_reg, float& l_reg,
                                            bf16x8 pk0 = bf16x8{}, bf16x8 pk1 = bf16x8{}, bf16x8 pv0 = bf16x8{}, bf16x8 pv1 = bf16x8{}) {
    const int r32 = lane & 31, hi = lane >> 5;
    LAS char* V_lds = lds; LAS char* K_lds = lds + 2 * SHM_V; LAS float* CB_lds = (LAS float*)(lds + 2 * SHM_V + 2 * SHM_K);
    LAS float* al_l = (LAS float*)(lds + 2 * SHM_V + 2 * SHM_K + 512) + wid * 64;
    const int sr = tid >> 4, sc = (tid & 15) * 8, vst0 = v_st(sr, sc), vst1 = v_st(32 + sr, sc), kws = KSWZ(sr, sc * 2);
    const int vb0 = (int)(unsigned)(uintptr_t)V_lds + v_rd_base(lane);
    const int qm = qpos - 4 * hi;
    f32x16 pA0, pA1, pB0, pB1; float mnA, mnB, alA, alB; bf16x8 pa0, pa1, pa2, pa3;
    bf16x8 st_v0, st_v1, st_k0, st_k1;
#define TILE(t) (DESC ? (j_lo + NT - 1 - (t)) : (j_lo + (t)))
#define KBASE(t) (TILE(t) * KVBLK)
#define VMW() asm volatile("s_waitcnt vmcnt(0)" ::: "memory")
#define SLOAD(k0, bf) do { st_v0 = *(const bf16x8*)(Vh + (size_t)((k0) + sr) * HD + sc); st_v1 = *(const bf16x8*)(Vh + (size_t)((k0) + 32 + sr) * HD + sc); \
        st_k0 = *(const bf16x8*)(Kh + (size_t)((k0) + sr) * HD + sc); st_k1 = *(const bf16x8*)(Kh + (size_t)((k0) + 32 + sr) * HD + sc); \
        if (MODE == M_FOX) { if (wid == 0) __builtin_amdgcn_global_load_lds((const unsigned*)(cb + (k0) + lane), (LAS unsigned*)(CB_lds + (bf) * 64), 4, 0, 0); } } while (0)
#define SWRITE(bf) do { *(LAS bf16x8*)(K_lds + (bf) * SHM_K + kws) = st_k0; *(LAS bf16x8*)(K_lds + (bf) * SHM_K + kws + 32 * 256) = st_k1; \
        *(LAS bf16x8*)(V_lds + (bf) * SHM_V + vst0) = st_v0; *(LAS bf16x8*)(V_lds + (bf) * SHM_V + vst1) = st_v1; } while (0)
#define RESC(a) do { if (__any((a) < 1.f)) { if (hi == 0) al_l[r32] = (a); asm volatile("s_waitcnt lgkmcnt(0)" ::: "memory");              \
                     for (int d_ = 0; d_ < 4; ++d_) for (int r = 0; r < 16; ++r) o[d_][r] *= al_l[crow(r, hi)]; } } while (0)
#define BIAS(P0_, P1_, bf) do { if (MODE == M_FOX) { const LAS float* cbp = CB_lds + (bf) * 64 + 4 * hi; \
        _Pragma("unroll") for (int g_ = 0; g_ < 4; ++g_) { const f32x4 c0 = *(const LAS f32x4*)(cbp + 8 * g_), c1 = *(const LAS f32x4*)(cbp + 32 + 8 * g_); \
            _Pragma("unroll") for (int i_ = 0; i_ < 4; ++i_) { P0_[4 * g_ + i_] += c0[i_]; P1_[4 * g_ + i_] += c1[i_]; } } } } while (0)
#define MASKT(P0_, P1_, t) do { const int kb_ = KBASE(t); \
        if (MODE == M_FOX) { if (kb_ + KVBLK - 1 > qlo) mask_tile(P0_, P1_, qm - kb_, 0x80000000u); } \
        else if (MODE == M_WIN) { if (kb_ + KVBLK - 1 > qlo || kb_ <= qhi - 512) mask_tile(P0_, P1_, qm - kb_, 512u); } \
        else { if (kb_ + KVBLK - 1 > qlo) mask_tile(P0_, P1_, qm - kb_, 0x80000000u); } } while (0)
#define LANEON(t) ((MODE != M_SEL) || (((TILE(t) < 32 ? (selLo >> TILE(t)) : (selHi >> (TILE(t) - 32))) & 1u) != 0u))
    __syncthreads();
    if (PRE) { st_k0 = pk0; st_k1 = pk1; st_v0 = pv0; st_v1 = pv1;
        if (MODE == M_FOX) { if (wid == 0) __builtin_amdgcn_global_load_lds((const unsigned*)(cb + KBASE(0) + lane), (LAS unsigned*)CB_lds, 4, 0, 0); } }
    else SLOAD(KBASE(0), 0);
    VMW(); SWRITE(0);
    if (NT > 1) SLOAD(KBASE(1), 1);
    __syncthreads();
    SBAR(); qkt(pA0, pA1, K_lds, r32, hi, qr);
    BIAS(pA0, pA1, 0); MASKT(pA0, pA1, 0); partialSM<MODE == M_SEL>(pA0, pA1, m_reg, mnA, alA, LANEON(0));
    if (NT > 1) { VMW(); SWRITE(1); }
    if (CONT) RESC(alA);
    __syncthreads();
#define HALF_STEP(PX0, PX1, mnX, alX, PY0, PY1, alY, t, KB, VB, SB) do {                                                      \
        SBAR(); qkt_fin<MODE == M_FOX>(PX0, PX1, K_lds + (KB) * SHM_K, r32, hi, qr, CB_lds + (KB) * 64 + 4 * hi, PY0, PY1, alY, l_reg, pa0, pa1, pa2, pa3); SBAR();        \
        if ((t) + 1 < NT) { SLOAD(KBASE((t) + 1), SB); SBAR(); }                                                                  \
        MASKT(PX0, PX1, (t)); SBAR();                                                                                          \
        pv_psm<(VB) * SHM_V, MODE == M_SEL>(o, V_lds + v_rd_base(lane), pa0, pa1, pa2, pa3, PX0, PX1, m_reg, mnX, alX, LANEON(t)); SBAR(); \
        __syncthreads();                                                                                                      \
        if ((t) + 1 < NT) { VMW(); SWRITE(SB); }                                                                              \
        RESC(alX); __syncthreads(); } while (0)
    for (int t = 1; t + 1 < NT; t += 2) {
        HALF_STEP(pB0, pB1, mnB, alB, pA0, pA1, alA, t, 1, 0, 0);
        HALF_STEP(pA0, pA1, mnA, alA, pB0, pB1, alB, t + 1, 0, 1, 1);
    }
    const bool even = (NT & 1) == 0;
    if (even) { SBAR(); qkt(pB0, pB1, K_lds + SHM_K, r32, hi, qr); SBAR(); }
    finishSM(pA0, pA1, alA, l_reg, pa0, pa1, pa2, pa3); SBAR();
    pv_tile<0>(o, vb0, pa0, pa1, pa2, pa3);
    if (even) { BIAS(pB0, pB1, 1); MASKT(pB0, pB1, NT - 1); partialSM<MODE == M_SEL>(pB0, pB1, m_reg, mnB, alB, LANEON(NT - 1)); __syncthreads(); RESC(alB);
        finishSM(pB0, pB1, alB, l_reg, pa0, pa1, pa2, pa3); SBAR(); pv_tile<SHM_V>(o, vb0, pa0, pa1, pa2, pa3); }
#undef HALF_STEP
#undef LANEON
#undef MASKT
#undef BIAS
#undef RESC
#undef SWRITE
#undef SLOAD
#undef VMW
#undef KBASE
#undef TILE
}
}

__device__ __forceinline__ void fox_unit(const Frame& F, int bh, int qb, float skip_margin, bool dummy = false) {
    using namespace att;
    const int wid = F.wave, P0 = qb * 256, qlo = P0 + wid * 32, b = bh >> 3, h = bh & 7;
    const bf16* Kh = ZP(Z_KF) + (size_t)bh * SEQ * HD; const bf16* Vh = ZP(Z_VF) + (size_t)bh * SEQ * HD; const float* cbh = (const float*)(F.ws + WS_Z + Z_CF) + (size_t)bh * SEQ;
    f32x16 o[4] = {}; float m_reg = -1e30f, l_reg = 0.f;
    bf16x8 qr[8], pk0, pk1, pv0, pv1;
#define FOX_IDS() const int lane = lane_id(), tid = wid * 64 + lane, r32 = lane & 31, hi = lane >> 5; (void)tid; (void)hi
#define FOX_LOADQ() { const bf16* Q = ZP(Z_QF) + ((size_t)bh * SEQ + qlo + r32) * HD; _Pragma("unroll") for (int d0 = 0; d0 < 8; ++d0) qr[d0] = *(const bf16x8*)(Q + d0 * 16 + hi * 8); }
    { FOX_IDS(); FOX_LOADQ();
      attn_stream<M_FOX>((LAS char*)F.lds, tid, wid, lane, qr, Kh, Vh, cbh, 4 * qb, 4, qlo + r32, qlo, qlo + 31, 0u, 0u, o, m_reg, l_reg);
      if (qb > 0) ATT_PRELOAD(Kh, Vh, (4 * qb - 1) * 64, tid, pk0, pk1, pv0, pv1); }
    if (qb > 0) {
        int j_lo;
        { FOX_IDS();
          float mm = fminf(m_reg, xlane<1>(m_reg)); mm = fminf(mm, xlane<2>(mm)); mm = fminf(mm, xlane<4>(mm)); mm = fminf(mm, xlane<8>(mm)); mm = fminf(mm, xlane<16>(mm));
          LAS float* mred = (LAS float*)(F.lds + 2 * SHM_V + 2 * SHM_K + 512);
          if (lane == 0) mred[wid * 64 + 48] = mm;
          __syncthreads();
          float T = mred[48];
#pragma unroll
          for (int w2 = 1; w2 < 8; ++w2) T = fminf(T, mred[w2 * 64 + 48]);
          T -= skip_margin;
          const bool sk = lane < 4 * qb && cbh[64 * lane + 63] < T;
          j_lo = __popcll(__ballot(sk)); }
        if (j_lo < 4 * qb) { FOX_IDS();
            attn_stream<M_FOX, true, true, true>((LAS char*)F.lds, tid, wid, lane, qr, Kh, Vh, cbh, j_lo, 4 * qb - j_lo, qlo + r32, qlo, qlo + 31, 0u, 0u, o, m_reg, l_reg, pk0, pk1, pv0, pv1); }
    }
    FOX_IDS();
    LAS float* li_l = (LAS float*)(F.lds + 2 * SHM_V + 2 * SHM_K + 512) + wid * 64 + 32;
    if (hi == 0) li_l[r32] = l_reg; LDS_WAIT();
    float rl[16];
#pragma unroll
    for (int r = 0; r < 16; ++r) rl[r] = __builtin_amdgcn_rcpf(li_l[crow(r, hi)]);
    __syncthreads();
    LAS float* img = (LAS float*)F.lds + wid * 4096;
#pragma unroll
    for (int r = 0; r < 16; ++r)
#pragma unroll
        for (int d0 = 0; d0 < 4; ++d0) img[crow(r, hi) * 128 + d0 * 32 + r32] = o[d0][r] * rl[r];
    LDS_WAIT();
    bf16* Y = ZP(Z_GC) + ((size_t)b * SEQ + qlo) * BW + h * HD; const long dofs = dummy ? (long)((bf16*)(F.ws + WS_X1) - ZP(Z_GC)) : 0;
    u32x4 gt[8];
#pragma unroll
    for (int it = 0; it < 8; ++it) { const int q = it * 64 + lane; gt[it] = *(const u32x4*)(Y + (size_t)(q >> 4) * BW + (q & 15) * 8); }
#pragma unroll
    for (int it = 0; it < 8; ++it) { const int q = it * 64 + lane; const f32x4 a = *(const LAS f32x4*)(img + (q >> 4) * 128 + (q & 15) * 8), c = *(const LAS f32x4*)(img + (q >> 4) * 128 + (q & 15) * 8 + 4);
        u32x4 y; y.x = cvt_pk_bf16(a.x * bf_lo(gt[it].x), a.y * bf_hi(gt[it].x)); y.y = cvt_pk_bf16(a.z * bf_lo(gt[it].y), a.w * bf_hi(gt[it].y));
        y.z = cvt_pk_bf16(c.x * bf_lo(gt[it].z), c.y * bf_hi(gt[it].z)); y.w = cvt_pk_bf16(c.z * bf_lo(gt[it].w), c.w * bf_hi(gt[it].w));
        *(u32x4*)(Y + dofs + (size_t)(q >> 4) * BW + (q & 15) * 8) = y; }
#undef FOX_IDS
#undef FOX_LOADQ
}

constexpr int NSA_OUT_OFF = 69632, NSA_IMP_OFF = RED_OFF;
#define NSA_IDS() const int lane = lane_id(), tid = wid * 64 + lane, r32 = lane & 31, hi = lane >> 5, tok = P0 + 8 * wid + (r32 >> 2), head = 4 * g + (r32 & 3); (void)tid; (void)hi; (void)tok; (void)head
#define NSA_PTRS() LAS float* fac = (LAS float*)(lds + MISC_OFF + 512) + wid * 64; LAS unsigned* oacc = (LAS unsigned*)(lds + NSA_OUT_OFF) + wid * 2048; \
        const float* BGp = (const float*)(F.ws + WS_Z + Z_BG) + ((size_t)b * SEQ + tok) * 24 + head * 3
#define NSA_LOADQ() { const bf16* Q = ZP(Z_QN) + ((size_t)(b * 8 + head) * SEQ + tok) * HD; _Pragma("unroll") for (int d0 = 0; d0 < 8; ++d0) qr[d0] = *(const bf16x8*)(Q + d0 * 16 + hi * 8); }
__device__ __forceinline__ void nsa_unit(const Frame& F, int bg, int blk, bool dummy = false) {
    using namespace att;
    const int wid = F.wave, P0 = blk * 64, b = bg >> 1, g = bg & 1, qlo = P0 + 8 * wid;
    LAS char* lds = (LAS char*)F.lds;
    constexpr float C2 = 1.4426950408889634f * SCALE;
    unsigned selLo, selHi;
    bf16x8 qr[8], pk0, pk1, pv0, pv1;
    const int jw_lo = blk >= 8 ? blk - 8 : 0;
    {
        NSA_IDS(); NSA_LOADQ();
        LAS float* impw = (LAS float*)(lds + NSA_IMP_OFF) + wid * 512;
        LAS unsigned* selm = (LAS unsigned*)(lds + MISC_OFF + 512) + wid * 64 + 32;
        const int nvm = P0 / 16 + 3, n_t = (nvm + 63) >> 6;
        const int nvis = tok >= 31 ? (tok - 31) / 16 + 1 : 0;
        LAS char* Kc = lds; LAS char* Vc = lds + 65536;
        __syncthreads();
        { const bf16* KC = (const bf16*)(F.ws + WS_KCMP) + (size_t)bg * 256 * HD; const bf16* VC = (const bf16*)(F.ws + WS_VCMP) + (size_t)bg * 256 * HD;
          const int sr = tid >> 4, sc = (tid & 15) * 8, vst0 = v_st(sr, sc), vst1 = v_st(32 + sr, sc), kws = KSWZ(sr, sc * 2);
          for (int ti = 0; ti < n_t; ti += 2) {
              const bool two = ti + 1 < n_t;
              const bf16x8 k0 = *(const bf16x8*)(KC + (size_t)(64 * ti + sr) * HD + sc), k1 = *(const bf16x8*)(KC + (size_t)(64 * ti + 32 + sr) * HD + sc);
              const bf16x8 v0 = *(const bf16x8*)(VC + (size_t)(64 * ti + sr) * HD + sc), v1 = *(const bf16x8*)(VC + (size_t)(64 * ti + 32 + sr) * HD + sc);
              bf16x8 k2 = k0, k3 = k1, v2 = v0, v3 = v1;
              if (two) { k2 = *(const bf16x8*)(KC + (size_t)(64 * ti + 64 + sr) * HD + sc); k3 = *(const bf16x8*)(KC + (size_t)(64 * ti + 96 + sr) * HD + sc);
                         v2 = *(const bf16x8*)(VC + (size_t)(64 * ti + 64 + sr) * HD + sc); v3 = *(const bf16x8*)(VC + (size_t)(64 * ti + 96 + sr) * HD + sc); }
              *(LAS bf16x8*)(Kc + ti * SHM_K + kws) = k0; *(LAS bf16x8*)(Kc + ti * SHM_K + kws + 32 * 256) = k1;
              *(LAS bf16x8*)(Vc + ti * SHM_V + vst0) = v0; *(LAS bf16x8*)(Vc + ti * SHM_V + vst1) = v1;
              if (two) { *(LAS bf16x8*)(Kc + (ti + 1) * SHM_K + kws) = k2; *(LAS bf16x8*)(Kc + (ti + 1) * SHM_K + kws + 32 * 256) = k3;
                         *(LAS bf16x8*)(Vc + (ti + 1) * SHM_V + vst0) = v2; *(LAS bf16x8*)(Vc + (ti + 1) * SHM_V + vst1) = v3; } } }
        for (int x = lane; x < 512; x += 64) impw[x] = 0.f;
        __syncthreads();
        float m = -1e30f, l = 0.f;
#pragma unroll
        for (int ti = 0; ti < 4; ++ti) if (ti < n_t) {
            f32x16 p0, p1; qkt(p0, p1, Kc + ti * SHM_K, r32, hi, qr);
            mask_tile(p0, p1, nvis - 1 - 64 * ti - 4 * hi, 0x80000000u);
            float pmax = p0[0];
#pragma unroll
            for (int r = 1; r < 16; ++r) pmax = fmaxf(pmax, p0[r]);
#pragma unroll
            for (int r = 0; r < 16; ++r) pmax = fmaxf(pmax, p1[r]);
            { auto rr = __builtin_amdgcn_permlane32_swap(__float_as_uint(pmax), __float_as_uint(pmax), false, false); pmax = fmaxf(__uint_as_float(rr[0]), __uint_as_float(rr[1])); }
            const float mn = fmaxf(m, pmax), mnL = -mn * C2; float ps = 0.f;
#pragma unroll
            for (int r = 0; r < 16; ++r) ps += __builtin_amdgcn_exp2f(fmaf(p0[r], C2, mnL)) + __builtin_amdgcn_exp2f(fmaf(p1[r], C2, mnL));
            ps = xsum32(ps);
            l = l * __builtin_amdgcn_exp2f((m - mn) * C2) + ps; m = mn;
        }
        const float rl = l > 0.f ? 1.0f / l : 0.f, mL = -m * C2;
        f32x16 o[4] = {};
        const int vbc = (int)(unsigned)(uintptr_t)Vc + v_rd_base(lane);
        LAS float* impt = impw + (r32 >> 2) * 64;
#define NSA_CMP_TILE(ti) do { if ((ti) < n_t) { \
            f32x16 p0, p1; qkt(p0, p1, Kc + (ti) * SHM_K, r32, hi, qr); \
            mask_tile(p0, p1, nvis - 1 - 64 * (ti) - 4 * hi, 0x80000000u); \
            _Pragma("unroll") for (int r = 0; r < 16; ++r) { p0[r] = __builtin_amdgcn_exp2f(fmaf(p0[r], C2, mL)) * rl; p1[r] = __builtin_amdgcn_exp2f(fmaf(p1[r], C2, mL)) * rl; } \
            _Pragma("unroll") for (int g4 = 0; g4 < 4; ++g4) { \
                float q0 = (p0[4 * g4] + p0[4 * g4 + 1]) + (p0[4 * g4 + 2] + p0[4 * g4 + 3]), e0 = p0[4 * g4 + 3], q1 = (p1[4 * g4] + p1[4 * g4 + 1]) + (p1[4 * g4 + 2] + p1[4 * g4 + 3]), e1 = p1[4 * g4 + 3]; \
                q0 += xlane<1>(q0); q0 += xlane<2>(q0); e0 += xlane<1>(e0); e0 += xlane<2>(e0); q1 += xlane<1>(q1); q1 += xlane<2>(q1); e1 += xlane<1>(e1); e1 += xlane<2>(e1);     \
                if ((r32 & 3) == 0) { const int j0 = 16 * (ti) + 2 * g4 + hi, j1 = j0 + 8; \
                    __hip_atomic_fetch_add(impt + j0, q0, __ATOMIC_RELAXED, __HIP_MEMORY_SCOPE_WORKGROUP); __hip_atomic_fetch_add(impt + j0 + 1, e0, __ATOMIC_RELAXED, __HIP_MEMORY_SCOPE_WORKGROUP); \
                    __hip_atomic_fetch_add(impt + j1, q1, __ATOMIC_RELAXED, __HIP_MEMORY_SCOPE_WORKGROUP); if (j1 < 63) __hip_atomic_fetch_add(impt + j1 + 1, e1, __ATOMIC_RELAXED, __HIP_MEMORY_SCOPE_WORKGROUP); } } \
            bf16x8 pa0, pa1, pa2, pa3; PK4(p0, 0, pa0); PK4(p0, 8, pa1); PK4(p1, 0, pa2); PK4(p1, 8, pa3); \
            pv_tile<(ti) * SHM_V>(o, vbc, pa0, pa1, pa2, pa3); } } while (0)
        NSA_CMP_TILE(0); NSA_CMP_TILE(1); NSA_CMP_TILE(2); NSA_CMP_TILE(3);
#undef NSA_CMP_TILE
        ATT_PRELOAD(ZP(Z_KS) + (size_t)bg * SEQ * HD, ZP(Z_VS) + (size_t)bg * SEQ * HD, 0, tid, pk0, pk1, pv0, pv1);
        LDS_WAIT();
        const float INF = __builtin_inff();
        for (int tl = 0; tl < 8; ++tl) {
            const bool fj = (lane == 0) || (lane == blk) || (lane == blk - 1);
            const float sj = fj ? INF : (lane <= blk ? impw[tl * 64 + lane] : -INF);
            int rank = 0;
#pragma unroll
            for (int x = 0; x < 64; ++x) { const float sx = __uint_as_float((unsigned)__builtin_amdgcn_readlane((int)__float_as_uint(sj), x)); rank += (sx > sj || (sx == sj && x < lane)) ? 1 : 0; }
            const unsigned long long bal = __ballot(rank < 16);
            if (lane == 0) { selm[tl * 2] = (unsigned)bal; selm[tl * 2 + 1] = (unsigned)(bal >> 32); }
        }
        LDS_WAIT();
        selLo = selm[(r32 >> 2) * 2]; selHi = selm[(r32 >> 2) * 2 + 1];
        NSA_PTRS();
        if (hi == 0) fac[r32] = BGp[0];
        __syncthreads();
#pragma unroll
        for (int r = 0; r < 16; r += 2) { const float f0 = fac[crow(r, hi)], f1 = fac[crow(r, hi) + 1];
#pragma unroll
            for (int d0 = 0; d0 < 4; ++d0) oacc[(d0 * 8 + (r >> 1)) * 64 + lane] = cvt_pk_bf16(o[d0][r] * f0, o[d0][r + 1] * f1); }
    }
    {
        f32x16 o[4] = {}; float m_reg = -1e30f, l_reg = 0.f;
        { NSA_IDS();
          attn_stream<M_SEL, false, true>(lds, tid, wid, lane, qr, ZP(Z_KS) + (size_t)bg * SEQ * HD, ZP(Z_VS) + (size_t)bg * SEQ * HD, nullptr, 0, blk + 1, tok, qlo, qlo + 7, selLo, selHi, o, m_reg, l_reg, pk0, pk1, pv0, pv1);
          ATT_PRELOAD(ZP(Z_KW) + (size_t)bg * SEQ * HD, ZP(Z_VW) + (size_t)bg * SEQ * HD, jw_lo * 64, tid, pk0, pk1, pv0, pv1); }
        NSA_IDS(); NSA_PTRS();
        if (hi == 0) fac[r32] = BGp[1] * __builtin_amdgcn_rcpf(l_reg);
        LDS_WAIT();
#pragma unroll
        for (int r = 0; r < 16; r += 2) { const float f0 = fac[crow(r, hi)], f1 = fac[crow(r, hi) + 1];
#pragma unroll
            for (int d0 = 0; d0 < 4; ++d0) { const unsigned w = oacc[(d0 * 8 + (r >> 1)) * 64 + lane];
                oacc[(d0 * 8 + (r >> 1)) * 64 + lane] = cvt_pk_bf16(bf_lo(w) + o[d0][r] * f0, bf_hi(w) + o[d0][r + 1] * f1); } }
    }
    {
        f32x16 o[4] = {}; float m_reg = -1e30f, l_reg = 0.f;
        { NSA_IDS();
          attn_stream<M_WIN, false, true>(lds, tid, wid, lane, qr, ZP(Z_KW) + (size_t)bg * SEQ * HD, ZP(Z_VW) + (size_t)bg * SEQ * HD, nullptr, jw_lo, blk - jw_lo + 1, tok, qlo, qlo + 7, 0u, 0u, o, m_reg, l_reg, pk0, pk1, pv0, pv1); }
        NSA_IDS(); NSA_PTRS();
        if (hi == 0) fac[r32] = BGp[2] * __builtin_amdgcn_rcpf(l_reg);
        LDS_WAIT();
#pragma unroll
        for (int r = 0; r < 16; r += 2) { const float f0 = fac[crow(r, hi)], f1 = fac[crow(r, hi) + 1];
#pragma unroll
            for (int d0 = 0; d0 < 4; ++d0) { const unsigned w = oacc[(d0 * 8 + (r >> 1)) * 64 + lane]; o[d0][r] = bf_lo(w) + o[d0][r] * f0; o[d0][r + 1] = bf_hi(w) + o[d0][r + 1] * f1; } }
        LAS bf16* img = (LAS bf16*)oacc;
#pragma unroll
        for (int r = 0; r < 16; ++r)
#pragma unroll
            for (int d0 = 0; d0 < 4; ++d0) img[crow(r, hi) * 128 + d0 * 32 + r32] = (bf16)f2bf(o[d0][r]);
        LDS_WAIT();
        bf16* Y = ZP(Z_GB) + ((size_t)b * SEQ + qlo) * BW + (4 * g) * HD; const long dofs = dummy ? (long)((bf16*)(F.ws + WS_X1) - ZP(Z_GB)) : 0;
        u32x4 gt[8];
#pragma unroll
        for (int it = 0; it < 8; ++it) { const int q = it * 64 + lane, row = q >> 4; gt[it] = *(const u32x4*)(Y + (size_t)(row >> 2) * BW + (row & 3) * HD + (q & 15) * 8); }
#pragma unroll
        for (int it = 0; it < 8; ++it) { const int q = it * 64 + lane, row = q >> 4; const u32x4 a = *(const LAS u32x4*)(img + row * 128 + (q & 15) * 8);
            u32x4 y; y.x = cvt_pk_bf16(bf_lo(a.x) * bf_lo(gt[it].x), bf_hi(a.x) * bf_hi(gt[it].x)); y.y = cvt_pk_bf16(bf_lo(a.y) * bf_lo(gt[it].y), bf_hi(a.y) * bf_hi(gt[it].y));
            y.z = cvt_pk_bf16(bf_lo(a.z) * bf_lo(gt[it].z), bf_hi(a.z) * bf_hi(gt[it].z)); y.w = cvt_pk_bf16(bf_lo(a.w) * bf_lo(gt[it].w), bf_hi(a.w) * bf_hi(gt[it].w));
            *(u32x4*)(Y + dofs + (size_t)(row >> 2) * BW + (row & 3) * HD + (q & 15) * 8) = y; }
    }
}
#undef NSA_IDS
#undef NSA_PTRS
#undef NSA_LOADQ

constexpr int N_PHASES = 1 + DEPTH * 8;

__device__ __forceinline__ void inproj_tail(const Frame& F, int l, const LayerW& W) {
    const int lane = lane_id(), fr = lane & 15, kq = lane >> 4;
    const int rows_per_wg = T / F.G, nsub = rows_per_wg / 16;
    const float* PS = (const float*)(F.ws + WS_PS); float* BG = (float*)(F.ws + WS_Z + Z_BG); float* LF = (float*)(F.ws + WS_Z + Z_LF);
    const bf16* Bt = W.Win + (size_t)(NIN - 32) * DM;
    constexpr int TP = 4112;
    __syncthreads();
    { const int tid = F.wave * 64 + lane;
#pragma unroll
      for (int jb = 0; jb < 16; jb += 8) { u32x4 w[8];
#pragma unroll
          for (int j = 0; j < 8; ++j) { const int e = tid + 512 * (jb + j); w[j] = *(const u32x4*)(Bt + (size_t)(e >> 8) * DM + (e & 255) * 8); }
#pragma unroll
          for (int j = 0; j < 8; ++j) { const int e = tid + 512 * (jb + j); *(LAS u32x4*)(F.lds + (e >> 8) * TP + (e & 255) * 16) = w[j]; } } }
    __syncthreads();
    for (int sub = F.wave; sub < nsub; sub += NWAVES) {
        const size_t row0 = (size_t)F.vcu * rows_per_wg + sub * 16;
        const bf16* ap = (const bf16*)(F.ws + WS_X2) + (row0 + fr) * DM + kq * 8;
        const LAS unsigned char* b0 = F.lds + fr * TP + kq * 16; const LAS unsigned char* b1 = b0 + 16 * TP;
        f32x4 c0 = {0.f, 0.f, 0.f, 0.f}, c1 = c0;
#pragma unroll 16
        for (int ks = 0; ks < DM / 32; ++ks) { const bf16x8 a = *(const bf16x8*)(ap + ks * 32), x0 = *(const LAS bf16x8*)(b0 + ks * 64), x1 = *(const LAS bf16x8*)(b1 + ks * 64);
            c0 = __builtin_amdgcn_mfma_f32_16x16x32_bf16(a, x0, c0, 0, 0, 0); c1 = __builtin_amdgcn_mfma_f32_16x16x32_bf16(a, x1, c1, 0, 0, 0); }
        const float bz0 = W.bias[NIN - 32 + fr], bz1 = W.bias[NIN - 16 + fr];
#pragma unroll
        for (int i = 0; i < 4; ++i) { const size_t row = row0 + 4 * kq + i; const float* pp = PS + row * 8; const f32x4 q0 = *(const f32x4*)pp, q1 = *(const f32x4*)(pp + 4);
            const float rs = 1.0f / sqrtf((((q0.x + q0.y) + (q0.z + q0.w)) + ((q1.x + q1.y) + (q1.z + q1.w))) * (1.f / DM) + EPS);
            const float v0 = c0[i] * rs + bz0, v1 = c1[i] * rs + bz1;
            BG[row * 24 + fr] = sigmoidf_(v0);
            if (fr < 8) BG[row * 24 + 16 + fr] = sigmoidf_(v1);
            else LF[row * 8 + (fr - 8)] = (v1 >= 0.f) ? -log1pf(__expf(-v1)) : (v1 - log1pf(__expf(v1))); }
    }
}
__device__ __forceinline__ void phase_inproj(const Frame& F0, int l, bool plain = false) {
    const Frame F = pin(F0); const LayerW W = layer_w(F.ws, l); const bf16* XA = (const bf16*)(F.ws + WS_X2);
    { PHASE_IDS(); const int gt = F.vcu * NTHREADS + tid;
      if (gt < 512) { const int j = gt >> 8, n = gt & 255; float sv = 0.f; for (int c = 0; c < 16; ++c) sv += W.posp[(j * 16 + c) * 256 + n]; W.posb[gt] = sv; } }
    inproj_tail(F, l, W); __syncthreads();
    int cur_pm = -1;
    { const bf16* A8 = (const bf16*)(F.ws + WS_A8);
      pg8::Gemm g{A8, A8, A8, W.Win, W.Win, W.Win}; pg8::StaticOrder<T, NIN - 32> S; S.init(F.G, (int)blockIdx.x);
      EpiIn E{F.ws, W.bias, INP(I_NQG) + (size_t)l * HD, INP(I_NKG) + (size_t)l * HD, INP(I_FQG) + (size_t)l * HD, INP(I_FKG) + (size_t)l * HD, (LAS float*)(F.lds + RED_OFF), (const float*)(F.ws + WS_PS), &cur_pm, plain, 0, 1.0f,
              (const float*)(F.ws + WS_RSE), W.sw, true};
      pg8::gemm_phase<DM / 2, DM, DM / 2, 1, 2>(F.lds, g, S, E, F.wave); }
}
__device__ __forceinline__ void phase_p3(const Frame& F0, int l) {
    const Frame F = pin(F0); const LayerW W = layer_w(F.ws, l);
    constexpr int nc = 32;
    if ((int)blockIdx.x < nc) {
        pg8::Gemm g{ZP(Z_KC), ZP(Z_VC), ZP(Z_VC), W.Wc1, W.Wc1 + (size_t)CMPH * 4096, W.Wc1}; pg8::OneEach S{16, 32, (int)blockIdx.x};
        EpiCmp E{W.posb, W.w2t, INP(I_NKG) + (size_t)l * HD, (bf16*)(F.ws + WS_KCMP), (bf16*)(F.ws + WS_VCMP)};
        pg8::gemm_phase<2048, 4096, 4096, 2>(F.lds, g, S, E, F.wave);
    } else {
        PHASE_IDS();
        const int nb = F.G - nc, me = (int)blockIdx.x - nc;
        for (int u = me; u < LRU_UNITS; u += nb) lru_unit<1>(F, tid, lane, l, u, W.gw);
        for (int it = me * NWAVES + F.wave; it < 64; it += nb * NWAVES) fox_cumsum_item(F, lane, it);
    }
}
__device__ __forceinline__ void phase_mixers(const Frame& F0, int l) {
    const Frame F = pin(F0);
    for (int rep = (REPMASK & 512) ? 0 : 1; rep < 2; ++rep) {
#pragma unroll 1
        for (int k = 0; k < 4; ++k) { const int it = (int)blockIdx.x + 256 * ((k + 2) & 3); const int pr = it % 512, bg = pr >> 5, x = pr & 31; nsa_unit(F, bg, it < 512 ? x : 63 - x, rep == 0); }
        __syncthreads(); }
    float skip_margin;
    { const int lane = lane_id(); const float* gq = INP(I_FQG) + (size_t)l * HD; const float* gk = INP(I_FKG) + (size_t)l * HD;
      float a = fmaxf(fabsf(gq[lane]), fabsf(gq[lane + 64])), c = fmaxf(fabsf(gk[lane]), fabsf(gk[lane + 64]));
      a = fmaxf(a, xlane<1>(a)); a = fmaxf(a, xlane<2>(a)); a = fmaxf(a, xlane<4>(a)); a = fmaxf(a, xlane<8>(a)); a = fmaxf(a, xlane<16>(a));
      c = fmaxf(c, xlane<1>(c)); c = fmaxf(c, xlane<2>(c)); c = fmaxf(c, xlane<4>(c)); c = fmaxf(c, xlane<8>(c)); c = fmaxf(c, xlane<16>(c));
      { auto rr = __builtin_amdgcn_permlane32_swap(__float_as_uint(a), __float_as_uint(a), false, false); a = fmaxf(__uint_as_float(rr[0]), __uint_as_float(rr[1])); }
      { auto rr = __builtin_amdgcn_permlane32_swap(__float_as_uint(c), __float_as_uint(c), false, false); c = fmaxf(__uint_as_float(rr[0]), __uint_as_float(rr[1])); }
      const float qkB = 1.02f * 11.313708499f * a * c;
      skip_margin = __uint_as_float((unsigned)__builtin_amdgcn_readfirstlane((int)__float_as_uint((qkB + 22.0f) * (1.0f / SCALE)))); }
    for (int rep = (REPMASK & 128) ? 0 : 1; rep < 2; ++rep) {
#pragma unroll 1
        for (int k = 0; k < 4; ++k) { const int it = (int)blockIdx.x + 256 * ((k + 2) & 3); const int pr = it % 512, bh = pr >> 3, x = pr & 7; fox_unit(F, bh, it < 512 ? x : 15 - x, skip_margin, rep == 0); }
        __syncthreads(); }
    for (int rep = (REPMASK & 16) ? 0 : 1; rep < 2; ++rep) {
        const int lane = lane_id(), tid = F.wave * 64 + lane;
        for (int u = (int)blockIdx.x; u < LRU_UNITS; u += F.G) lru_unit<2>(F, tid, lane, l, u, layer_w(F.ws, l).gw, rep == 0);
        __syncthreads(); }
}
__device__ __forceinline__ void phase_branch(const Frame& F0, int l) {
    const Frame F = pin(F0); const LayerW W = layer_w(F.ws, l);
    pg8::Gemm g{ZP(Z_GA), ZP(Z_GB), ZP(Z_GC), W.Wbr, W.Wbr + (size_t)DM * BW, W.Wbr + (size_t)2 * DM * BW}; pg8::StaticOrder<T, DM, 3> S; S.init(F.G, (int)blockIdx.x);
    EpiBranch E{(const unsigned char*)ZP(Z_MG), ZP(Z_QF)}; pg8::gemm_phase<BW, BW, BW, 3>(F.lds, g, S, E, F.wave);
}
__device__ __forceinline__ void phase_eraw(const Frame& F0, int l) {
    const Frame F = pin(F0); const LayerW W = layer_w(F.ws, l);
    const bf16* pbf = (const bf16*)(F.ws + WS_PB) + (size_t)l * T * PLE; bf16* X1 = (bf16*)(F.ws + WS_X1);
    pg8::Gemm g{pbf, pbf, pbf, W.Wple, W.Wple, W.Wple}; pg8::StaticOrder<T, DM> S; S.init(F.G, (int)blockIdx.x);
    EpiEraw E{X1, (float*)(F.ws + WS_PSE), (LAS float*)(F.lds + RED_OFF)}; pg8::gemm_phase<PLE, PLE, PLE, 1>(F.lds, g, S, E, F.wave);
}
__device__ __forceinline__ void phase_outproj(const Frame& F0, int l, bool dummy = false) {
    const Frame F = pin(F0); const LayerW W = layer_w(F.ws, l);
    const bf16* MR = I8_P6 ? ZP(Z_GA) : ZP(Z_QF);
    pg8::Gemm g{MR, MR, MR, W.Wout, W.Wout, W.Wout}; pg8::StaticOrder<T, DM> S; S.init(F.G, (int)blockIdx.x);
    EpiOut E{(l == 0) ? INP(I_X) : nullptr, (const bf16*)(F.ws + WS_X2), dummy ? ZP(Z_MG) : (bf16*)(F.ws + WS_X0), (const float*)(F.ws + WS_HID + MiB), W.so};
    if (I8_P6) pg8::gemm_phase<DM / 2, DM, DM / 2, 1, 2>(F.lds, g, S, E, F.wave); else pg8::gemm_phase<DM, DM, DM, 1>(F.lds, g, S, E, F.wave);
}
__device__ __forceinline__ void phase_gate(const Frame& F0, int l, bool dummy = false) {
    const Frame F = pin(F0); const LayerW W = layer_w(F.ws, l);
    const bf16* X0 = (const bf16*)(F.ws + WS_X0); const bf16* AO = I8_P7 ? ZP(Z_U) : X0;
    pg8::Gemm g{AO, AO, AO, W.Wgate, W.Wgate, W.Wgate}; pg8::StaticOrder<T, DM> S; S.init(F.G, (int)blockIdx.x);
    EpiGate E{X0, dummy ? (float*)(F.ws + WS_Z + Z_MG) : (l == DEPTH - 1 ? F.out : nullptr), (const bf16*)(F.ws + WS_X1), (const float*)(F.ws + WS_PSE), INP(I_PLEG) + (size_t)l * DM,
              dummy ? ZP(Z_MG) + (size_t)128 * MiB : (l == DEPTH - 1 ? nullptr : (bf16*)(F.ws + WS_X2)),        dummy ? (float*)(F.ws + WS_Z + Z_LF) : (float*)(F.ws + WS_PS), (LAS float*)(F.lds + RED_OFF), (const float*)(F.ws + WS_HID), W.sg};
    if (I8_P7) pg8::gemm_phase<DM / 2, DM, DM / 2, 1, 2>(F.lds, g, S, E, F.wave); else pg8::gemm_phase<DM, DM, DM, 1>(F.lds, g, S, E, F.wave);
}

__global__ void __launch_bounds__(NTHREADS, 2) fwd_kernel(Args args) {
    extern __shared__ __attribute__((aligned(16))) unsigned char lds_raw[];
    Frame F;
    F.lds = (LAS unsigned char*)lds_raw;
    F.wave = __builtin_amdgcn_readfirstlane((int)threadIdx.x >> 6);
    F.G = gridDim.x; { const int bx = blockIdx.x; F.vcu = (F.G % 8 == 0) ? (bx % 8) * (F.G / 8) + bx / 8 : bx; }
    F.A = (const CAS ArgsG*)__builtin_amdgcn_kernarg_segment_ptr(); F.out_g = F.A->out; F.ws_g = F.A->ws; F.out = (float*)F.out_g; F.ws = (unsigned char*)F.ws_g;
    volatile LAS unsigned* MISC = (volatile LAS unsigned*)(F.lds + MISC_OFF);
    { const int l0 = lane_id(); if (F.wave == 0 && l0 < 32) MISC[l0] = 0u; }
    __syncthreads();
    XcdBarrier bar; bar.bar = (unsigned*)(F.ws + WS_CTL) + CW_BAR; bar.x = 0; bar.st = nullptr;
    if (!MK_PER_PHASE) bar = xcd_barrier_post((unsigned*)(F.ws + WS_CTL) + CW_BAR, MISC + 8, F.wave == 0 && lane_id() == 0);
    const int lo = F.A->ph_lo, hi = F.A->ph_hi;
#define IN(k) (lo <= (k) && (k) < hi)
#define SEAM(k) do { if (IN((k) + 1)) { if (MK_PER_PHASE) { } else xcd_barrier(bar, F.wave == 0 && lane_id() == 0); } } while (0)

    if (IN(0)) { phase_prologue(F); if (!P0_FUSEQ) { xcd_barrier(bar, F.wave == 0 && lane_id() == 0); phase_quant_w(F); } SEAM(0); }

    for (int l = 0; l < DEPTH; ++l) {
        const int pb = 1 + l * 8;
        if (IN(pb + 0) && l > 0) { phase_quant_a(F); SEAM(pb + 0); }
        if (IN(pb + 1) && !(SKIPMASK & 2)) { if (REPMASK & 4096) phase_inproj(F, l, true); phase_inproj(F, l); if (REPMASK & 2) phase_inproj(F, l); SEAM(pb + 1); }
        if (IN(pb + 2) && !(SKIPMASK & 4)) { phase_p3(F, l); if (REPMASK & 4) phase_p3(F, l); SEAM(pb + 2); }
        if (IN(pb + 4) && !(SKIPMASK & 16)) { phase_mixers(F, l); SEAM(pb + 4); }
        if (IN(pb + 5) && !(SKIPMASK & 32)) { phase_branch(F, l); if (REPMASK & 32) phase_branch(F, l); phase_eraw(F, l); if (REPMASK & 64) phase_eraw(F, l); SEAM(pb + 5);
            if (I8_P6) { phase_quant_a(F, WS_Z + Z_QF, WS_Z + Z_GA, WS_HID + MiB); xcd_barrier(bar, F.wave == 0 && lane_id() == 0); } }
        if (IN(pb + 6) && !(SKIPMASK & 64)) { if (REPMASK & 1024) phase_outproj(F, l, true); phase_outproj(F, l); SEAM(pb + 6);
            if (I8_P7) { phase_quant_a(F, WS_X0, WS_Z + Z_U, WS_HID); xcd_barrier(bar, F.wave == 0 && lane_id() == 0); } }
        if (IN(pb + 7) && !(SKIPMASK & 128)) { if (REPMASK & 2048) phase_gate(F, l, true); phase_gate(F, l); SEAM(pb + 7); }
    }
#undef IN
#undef SEAM
}

extern "C" void kernel_launch(void* const* d_in, const int* in_sizes, int n_in, void* d_out, int out_size, void* d_ws, size_t ws_size, hipStream_t stream) {
    static int grid = 0;
    if (grid == 0) {
        if (n_in != 24 || in_sizes[0] != T * DM || out_size != T * DM || ws_size < WS_END) {
            fprintf(stderr, "kernel_launch: unexpected shapes (n_in %d, in0 %d, out %d, ws %zu < %zu); nothing launched\n", n_in, n_in > 0 ? in_sizes[0] : -1, out_size, ws_size, (size_t)WS_END); grid = -1; return; }
        int dev = 0, cus = 0, per_cu = 0;
        if (hipGetDevice(&dev) != hipSuccess || hipDeviceGetAttribute(&cus, hipDeviceAttributeMultiprocessorCount, dev) != hipSuccess) { grid = -1; return; }
        if (hipFuncSetAttribute((const void*)fwd_kernel, hipFuncAttributeMaxDynamicSharedMemorySize, LDS_BYTES) != hipSuccess) { fprintf(stderr, "kernel_launch: hipFuncSetAttribute failed\n"); grid = -1; return; }
        if (hipOccupancyMaxActiveBlocksPerMultiprocessor(&per_cu, (const void*)fwd_kernel, NTHREADS, LDS_BYTES) != hipSuccess || per_cu < 1) {
            fprintf(stderr, "kernel_launch: occupancy query reports %d workgroups per CU; nothing launched\n", per_cu); (void)hipGetLastError(); grid = -1; return; }
        if (cus < 256) { fprintf(stderr, "kernel_launch: this kernel is laid out for the 256 CUs of an MI355X (found %d); nothing launched\n", cus); grid = -1; return; }
        grid = 256;
    }
    if (grid < 0) return;
    (void)hipMemsetAsync((char*)d_ws + WS_CTL, 0, CTL_ZERO_BYTES, stream);
    Args a{};
    for (int i = 0; i < 24; ++i) a.in[i] = (const float*)d_in[i];
    a.out = (float*)d_out; a.ws = (unsigned char*)d_ws;
#if MK_PER_PHASE
    for (int p = 0; p < N_PHASES; ++p) { a.ph_lo = p; a.ph_hi = p + 1; hipLaunchKernelGGL(fwd_kernel, dim3(grid), dim3(NTHREADS), LDS_BYTES, stream, a); }
#else
    a.ph_lo = 0; a.ph_hi = N_PHASES;
    hipLaunchKernelGGL(fwd_kernel, dim3(grid), dim3(NTHREADS), LDS_BYTES, stream, a);
#endif
    const hipError_t le = hipPeekAtLastError();
    if (le != hipSuccess) fprintf(stderr, "kernel_launch: launch failed: %s\n", hipGetErrorName(le));
}
```

```cpp
#include <hip/hip_runtime.h>
#include <cstdio>
#include <cstdint>

#ifndef SKIPMASK
#define SKIPMASK 0
#endif
#ifndef REPMASK
#define REPMASK 0
#endif
#ifndef P0_FUSEQ
#define P0_FUSEQ 1
#endif
#ifndef I8_P7
#define I8_P7 1
#endif
#ifndef I8_P6
#define I8_P6 1
#endif
#ifndef INPROJ_SP2
#define INPROJ_SP2 true
#endif
#ifndef MK_PER_PHASE
#define MK_PER_PHASE 0
#endif

#define GAS __attribute__((address_space(1)))
#define LAS __attribute__((address_space(3)))
typedef unsigned short bf16;
typedef short bf16x8 __attribute__((ext_vector_type(8)));
typedef float f32x4 __attribute__((ext_vector_type(4)));
typedef float f32x2 __attribute__((ext_vector_type(2)));
typedef unsigned u32x4 __attribute__((ext_vector_type(4)));
typedef unsigned u32x2 __attribute__((ext_vector_type(2)));

constexpr int DM = 2048, NBATCH = 8, SEQ = 4096, DEPTH = 4, T = NBATCH * SEQ, HD = 128, BW = 1024, PLE = 256;
constexpr int NIN = 15904, NINP = 16128;
constexpr int NCMP = 255, CMPH = 256;
constexpr int MRG0 = 38 * 256;
constexpr float EPS = 1e-6f;
constexpr float SCALE = 0.08838834764831845f;
constexpr int NWAVES = 8, NTHREADS = 512;

__host__ __device__ __forceinline__ int nmap(int n) {
    if (n < 4608) return n;
    if (n < 4632) return 15872 + (n - 4608);
    if (n < 8728) return n - 24;
    if (n < 8736) return 15896 + (n - 8728);
    return n - 32;
}

constexpr size_t MiB = 1u << 20;
constexpr size_t WS_CTL = 0, CTL_ZERO_BYTES = 1 * MiB;
constexpr size_t WL_IN = 0, WL_BR = 63 * MiB, WL_OUT = 75 * MiB, WL_GATE = 83 * MiB, WL_PLE = 91 * MiB, WL_C1 = 92 * MiB, WL_MISC = 96 * MiB, WL_STRIDE = 97 * MiB;
constexpr size_t WM_BIAS = 0, WM_POSB = 128 * 1024, WM_POSP = 256 * 1024, WM_GW = 512 * 1024, WM_W2T = 768 * 1024, WM_SW = 384 * 1024, WM_SG = 448 * 1024, WM_SO = 456 * 1024;
constexpr size_t WS_W = 1 * MiB;
constexpr size_t WS_Z = WS_W + DEPTH * WL_STRIDE;
constexpr size_t Z_U = 0, Z_GA = 64 * MiB, Z_GB = 128 * MiB, Z_GC = 192 * MiB, Z_QN = 256 * MiB, Z_QF = 320 * MiB, Z_KF = 384 * MiB, Z_VF = 448 * MiB;
constexpr size_t Z_KC = 512 * MiB, Z_VC = 528 * MiB, Z_KS = 544 * MiB, Z_VS = 560 * MiB, Z_KW = 576 * MiB, Z_VW = 592 * MiB, Z_MG = 608 * MiB;
constexpr size_t Z_BG = 992 * MiB, Z_LF = 995 * MiB, Z_CF = 996 * MiB, Z_END = 997 * MiB;
constexpr size_t WS_X0 = WS_Z + Z_END;
constexpr size_t WS_X1 = WS_X0 + 128 * MiB;
constexpr size_t WS_X2 = WS_X1 + 128 * MiB;
constexpr size_t WS_PB = WS_X2 + 128 * MiB;
constexpr size_t WS_HID = WS_PB + 64 * MiB;
constexpr size_t WS_KCMP = WS_HID + 4 * MiB, WS_VCMP = WS_KCMP + 1 * MiB;
constexpr size_t WS_RSE = WS_VCMP + 1 * MiB;
constexpr size_t WS_LRUS = WS_RSE + 1 * MiB;
constexpr size_t WS_PS = WS_LRUS + 4 * MiB;
constexpr size_t WS_PSE = WS_PS + 1 * MiB;
constexpr size_t WS_A8 = WS_PSE + 1 * MiB;
constexpr size_t WS_END = WS_A8 + 64 * MiB;
constexpr int CW_BAR = 4096;

constexpr int RING_BYTES = 131072;
constexpr int RED_OFF = RING_BYTES, SCR_BYTES = 16384;
constexpr int MISC_OFF = RED_OFF + SCR_BYTES;
constexpr int LDS_BYTES = MISC_OFF + 4096;

__device__ __forceinline__ float bf_lo(unsigned w) { return __uint_as_float(w << 16); }
__device__ __forceinline__ float bf_hi(unsigned w) { return __uint_as_float(w & 0xffff0000u); }
__device__ __forceinline__ float bf2f(bf16 h) { return __uint_as_float(((unsigned)h) << 16); }
__device__ __forceinline__ unsigned f2bf(float f) { unsigned u = __float_as_uint(f); return (u + 0x7fffu + ((u >> 16) & 1u)) >> 16; }
__device__ __forceinline__ unsigned pk2(float lo, float hi) { return f2bf(lo) | (f2bf(hi) << 16); }
__device__ __forceinline__ unsigned pk4_i8(float a, float b, float c, float d) { return ((unsigned)(int)a & 0xffu) | (((unsigned)(int)b & 0xffu) << 8) | (((unsigned)(int)c & 0xffu) << 16) | (((unsigned)(int)d & 0xffu) << 24); }
__device__ __forceinline__ unsigned cvt_pk_bf16(float lo, float hi) { unsigned r; asm volatile("v_cvt_pk_bf16_f32 %0, %1, %2" : "=v"(r) : "v"(lo), "v"(hi)); return r; }
__device__ __forceinline__ float sigmoidf_(float x) { return __builtin_amdgcn_rcpf(1.0f + __builtin_amdgcn_exp2f(-1.4426950408889634f * x)); }
template <int M> __device__ __forceinline__ int xlane_i(int v) { static_assert(M >= 1 && M < 32, "swizzle: xor mask within a 32-lane half"); return __builtin_amdgcn_ds_swizzle(v, (M << 10) | 0x1f); }
template <int M> __device__ __forceinline__ float xlane(float v) { return __int_as_float(xlane_i<M>(__float_as_int(v))); }
__device__ __forceinline__ float xsum32(float v) { auto rr = __builtin_amdgcn_permlane32_swap(__float_as_uint(v), __float_as_uint(v), false, false); return __uint_as_float(rr[0]) + __uint_as_float(rr[1]); }
__device__ __forceinline__ float wave_sum(float v) {
    v += xlane<1>(v); v += xlane<2>(v); v += xlane<4>(v); v += xlane<8>(v); v += xlane<16>(v); return xsum32(v);
}
__device__ __forceinline__ int lane_id() { int l; asm volatile("v_mbcnt_lo_u32_b32 %0, -1, 0\n\tv_mbcnt_hi_u32_b32 %0, -1, %0" : "=v"(l)); return l; }
__device__ __forceinline__ float clamp8(float x) { return fminf(fmaxf(x, -448.f), 448.f); }
__device__ __forceinline__ unsigned pk4_fp8(float a, float b, float c, float d) { int w = __builtin_amdgcn_cvt_pk_fp8_f32(clamp8(a), clamp8(b), 0, false); w = __builtin_amdgcn_cvt_pk_fp8_f32(clamp8(c), clamp8(d), w, true); return (unsigned)w; }
#define LDS_WAIT() asm volatile("s_waitcnt lgkmcnt(0)" ::: "memory")
#define VM_WAIT() asm volatile("s_waitcnt vmcnt(0)" ::: "memory")

namespace pg8 {
constexpr int BM = 256, BK = 64, HALF = 128, HTB = HALF * BK * 2, STAGE_BYTES = 8 * HTB, NXCD = 8, WGM = 4;
__host__ __device__ __forceinline__ int lds_byte(int r, int c) { const int st = (r >> 4) * 2 + (c >> 5), rr = r & 15, cc = c & 31, ob = rr * 64 + cc * 2; return st * 1024 + (ob ^ (((ob >> 9) & 1) << 5)); }
__host__ __device__ __forceinline__ void stage_rc(int b, int& R, int& C) { const int st = b / 1024, sb = b % 1024, swz = sb ^ (((sb >> 9) & 1) << 5); R = (st >> 1) * 16 + swz / 64; C = (st & 1) * 32 + (swz % 64) / 2; }
__host__ __device__ __forceinline__ int perm32(int rho) { const int n = rho >> 4, i = rho & 15; return 8 * (i >> 2) + 4 * n + (i & 3); }

struct Unit { int pm, pn, seg; };
struct Gemm { const bf16* A0; const bf16* A1; const bf16* A2; const bf16* B0; const bf16* B1; const bf16* B2; };

template <int M_, int N_, int NSEG = 1> struct StaticOrder {
    static constexpr int nM = M_ / BM, nN = N_ / BM, nwg = nM * nN;
    int G, c;
    __device__ void init(int G_, int c_) { G = G_; c = c_; }
    __device__ bool next(int i, Unit& u) const {
        const int it = i / NSEG; u.seg = i - it * NSEG;
        const long L = (long)it * G + c; if (L >= nwg) return false;
        int wgid = (int)L; { const int q = nwg / NXCD, r = nwg % NXCD, xcd = wgid % NXCD, off = wgid / NXCD; wgid = (xcd < r ? xcd * (q + 1) : r * (q + 1) + (xcd - r) * q) + off; }
        const int nig = WGM * nN, gid = wgid / nig, fm = gid * WGM, gsz = (nM - fm) < WGM ? (nM - fm) : WGM;
        u.pm = fm + ((wgid % nig) % gsz); u.pn = (wgid % nig) / gsz; return true;
    }
};
struct OneEach {
    int nM, n, c;
    __device__ bool next(int i, Unit& u) const { if (i > 0 || c >= n) return false; u.pm = c % nM; u.pn = 0; u.seg = c / nM; return true; }
};

typedef f32x4 Acc[2][2][4][2];
__device__ __forceinline__ void zero_acc(Acc& acc) {
#pragma unroll
    for (int a = 0; a < 2; ++a)
#pragma unroll
        for (int b = 0; b < 2; ++b)
#pragma unroll
            for (int m = 0; m < 4; ++m)
#pragma unroll
                for (int n = 0; n < 2; ++n) acc[a][b][m][n] = (f32x4){0.f, 0.f, 0.f, 0.f};
}

template <int LDA, int LDB, int K, int NSEG, int MODE = 0, class Epi, class Sched>
__device__ __forceinline__ void gemm_phase(LAS unsigned char* lds, const Gemm g, const Sched& S, const Epi& E, int wid) {
    constexpr bool FP8 = MODE == 1, I8 = MODE == 2;
    const int lane = lane_id(), tid = wid * 64 + lane;
    const int wr = wid >> 2, wc = wid & 3, fr = lane & 15, fq = lane >> 4;
    constexpr int nt = K / BK;
    unsigned voffA[2], voffB[2];
#pragma unroll
    for (int i = 0; i < 2; ++i) { int R, C; stage_rc(tid * 16 + i * 8192, R, C); const int Rb = (R & ~31) + perm32(R & 31);
        if (FP8) C = 8 * (2 * ((C & 31) >> 3) + (C >> 5));
        voffA[i] = (unsigned)(R * LDA + C) * 2u; voffB[i] = (unsigned)(Rb * LDB + C) * 2u; }
    constexpr size_t kstep = (size_t)(BK * 2);
    constexpr size_t hstepA = (size_t)HALF * LDA * 2, hstepB = (size_t)HALF * LDB * 2;
    constexpr size_t tstepA = 2 * hstepA, tstepB = 2 * hstepB;
    const unsigned ldsw = (unsigned)wid * 1024u;
    const int aoff = lds_byte(wr * 64 + fr, fq * 8), boff = lds_byte(wc * 32 + fr, fq * 8);
#define PG8_SA(b, h) (((b) * 2 + (h)) * HTB)
#define PG8_SB(b, h) ((4 + (b) * 2 + (h)) * HTB)
#define PG8_STAGE(bufoff, gbase, voff) do { _Pragma("unroll") for (int _i = 0; _i < 2; ++_i) \
        __builtin_amdgcn_global_load_lds((const unsigned*)((const char*)(gbase) + (voff)[_i]), (LAS unsigned*)(lds + (bufoff) + ldsw + _i * 8192), 16, 0, 0); } while (0)
    typedef int v8i_ __attribute__((ext_vector_type(8))); typedef int v4i_ __attribute__((ext_vector_type(4)));
#define PG8_LD8(dst, idx, addr) do { const v4i_ lo_ = *(const LAS v4i_*)(addr), hi_ = *(const LAS v4i_*)((addr) + 1024); dst[idx] = __builtin_shufflevector(lo_, hi_, 0, 1, 2, 3, 4, 5, 6, 7); } while (0)
#define PG8_LDA(dst, b, h) do { if constexpr (FP8) { _Pragma("unroll") for (int m = 0; m < 4; ++m) PG8_LD8(dst##8, m, lds + PG8_SA(b, h) + aoff + m * 2048); } \
        else { _Pragma("unroll") for (int m = 0; m < 4; ++m) _Pragma("unroll") for (int k = 0; k < 2; ++k) dst[m][k] = *(const LAS bf16x8*)(lds + PG8_SA(b, h) + aoff + m * 2048 + k * 1024); } } while (0)
#define PG8_LDB(dst, b, h) do { if constexpr (FP8) { _Pragma("unroll") for (int n = 0; n < 2; ++n) PG8_LD8(dst##8, n, lds + PG8_SB(b, h) + boff + n * 2048); } \
        else { _Pragma("unroll") for (int n = 0; n < 2; ++n) _Pragma("unroll") for (int k = 0; k < 2; ++k) dst[n][k] = *(const LAS bf16x8*)(lds + PG8_SB(b, h) + boff + n * 2048 + k * 1024); } } while (0)
#define PG8_MMA(ai, bj, At, Bt) do { __builtin_amdgcn_s_setprio(1); _Pragma("unroll") for (int m = 0; m < 4; ++m) _Pragma("unroll") for (int n = 0; n < 2; ++n) { \
        if constexpr (FP8) asm volatile("v_mfma_f32_16x16x128_f8f6f4 %0, %1, %2, %0" : "+v"(acc[ai][bj][m][n]) : "v"(Bt##8[n]), "v"(At##8[m]));     \
        else if constexpr (I8) { _Pragma("unroll") for (int k = 0; k < 2; ++k) asm volatile("v_mfma_i32_16x16x64_i8 %0, %1, %2, %0" : "+v"(acc[ai][bj][m][n]) : "v"(Bt[n][k]), "v"(At[m][k])); }     \
        else { _Pragma("unroll") for (int k = 0; k < 2; ++k) acc[ai][bj][m][n] = __builtin_amdgcn_mfma_f32_16x16x32_bf16(Bt[n][k], At[m][k], acc[ai][bj][m][n], 0, 0, 0); } } \
        __builtin_amdgcn_s_setprio(0); } while (0)
#define PG8_WAIT_V(n) asm volatile("s_waitcnt vmcnt(" #n ")" ::: "memory")
#define PG8_WAIT_L(n) asm volatile("s_waitcnt lgkmcnt(" #n ")" ::: "memory")
#define PG8_BAR __builtin_amdgcn_s_barrier()
#define PG8_SCHED __builtin_amdgcn_sched_barrier(0)
#define PG8_APTR(u) ((const char*)((NSEG == 1 || (u).seg == 0) ? g.A0 : ((NSEG == 2 || (u).seg == 1) ? g.A1 : g.A2)) + (size_t)(u).pm * tstepA)
#define PG8_BPTR(u) ((const char*)((NSEG == 1 || (u).seg == 0) ? g.B0 : ((NSEG == 2 || (u).seg == 1) ? g.B1 : g.B2)) + (size_t)(u).pn * tstepB)
    Unit cur, nxt; int ui = 0;
    if (!S.next(0, cur)) return;
    Acc acc; zero_acc(acc);
    bf16x8 At[4][2], B0[2][2], B1[2][2]; v8i_ At8[4], B08[2], B18[2];
    const char* cA = PG8_APTR(cur); const char* cB = PG8_BPTR(cur);
    PG8_STAGE(PG8_SB(0, 0), cB, voffB); PG8_STAGE(PG8_SB(0, 1), cB + hstepB, voffB); PG8_STAGE(PG8_SA(0, 0), cA, voffA); PG8_STAGE(PG8_SA(0, 1), cA + hstepA, voffA);
    if (wr == 1) PG8_BAR;
    PG8_WAIT_V(2); PG8_BAR;
    PG8_STAGE(PG8_SB(1, 0), cB + kstep, voffB); PG8_STAGE(PG8_SA(1, 0), cA + kstep, voffA); PG8_STAGE(PG8_SB(1, 1), cB + hstepB + kstep, voffB);
    PG8_WAIT_V(6); PG8_BAR;
    for (;;) {
        const bool has_next = S.next(ui + 1, nxt);
        const char* nA = has_next ? PG8_APTR(nxt) : cA; const char* nB = has_next ? PG8_BPTR(nxt) : cB;
#pragma unroll 1
        for (int t = 0; t < nt; t += 2) {
            const bool last = (t == nt - 2);
            const char* a1 = cA + (size_t)(t + 1) * kstep;
            const char* a2 = last ? nA : cA + (size_t)(t + 2) * kstep; const char* b2 = last ? nB : cB + (size_t)(t + 2) * kstep;
            const char* a3 = a2 + kstep; const char* b3 = b2 + kstep;
            PG8_LDB(B0, 0, 0); PG8_LDB(B1, 0, 1); PG8_SCHED; PG8_LDA(At, 0, 0); PG8_STAGE(PG8_SA(1, 1), a1 + hstepA, voffA);
            PG8_WAIT_V(8); PG8_WAIT_L(0); PG8_BAR; PG8_MMA(0, 0, At, B0); PG8_MMA(0, 1, At, B1); PG8_BAR; PG8_SCHED;
            PG8_LDA(At, 0, 1); PG8_STAGE(PG8_SB(0, 0), b2, voffB); PG8_STAGE(PG8_SB(0, 1), b2 + hstepB, voffB); PG8_STAGE(PG8_SA(0, 0), a2, voffA);
            PG8_WAIT_V(8); PG8_WAIT_L(0); PG8_BAR; PG8_MMA(1, 0, At, B0); PG8_MMA(1, 1, At, B1); PG8_BAR; PG8_SCHED;
            PG8_LDB(B0, 1, 0); PG8_LDB(B1, 1, 1); PG8_SCHED; PG8_LDA(At, 1, 0); PG8_STAGE(PG8_SA(0, 1), a2 + hstepA, voffA);
            PG8_WAIT_V(8); PG8_WAIT_L(0); PG8_BAR; PG8_MMA(0, 0, At, B0); PG8_MMA(0, 1, At, B1); PG8_BAR; PG8_SCHED;
            PG8_LDA(At, 1, 1); PG8_STAGE(PG8_SB(1, 0), b3, voffB); PG8_STAGE(PG8_SB(1, 1), b3 + hstepB, voffB); PG8_STAGE(PG8_SA(1, 0), a3, voffA);
            PG8_WAIT_V(8); PG8_WAIT_L(0); PG8_BAR; PG8_MMA(1, 0, At, B0); PG8_MMA(1, 1, At, B1); PG8_BAR; PG8_SCHED;
        }
        if (wr == 0) PG8_BAR;
        if constexpr (FP8 || I8) asm volatile("s_nop 15\n\ts_nop 15" ::: "memory");
        if constexpr (!Epi::AFTER_DRAIN) E(acc, cur, wr, wc, fr, fq);
        if (!has_next) break;
        cur = nxt; cA = nA; cB = nB; ++ui;
        if (wr == 1) PG8_BAR;
    }
    PG8_WAIT_V(0);
    PG8_BAR;
    if constexpr (Epi::AFTER_DRAIN) E.fused(acc, cur, wr, wc, fr, fq, lds, wid, lane);
#undef PG8_SA
#undef PG8_SB
#undef PG8_STAGE
#undef PG8_LDA
#undef PG8_LD8
#undef PG8_LDB
#undef PG8_MMA
#undef PG8_WAIT_V
#undef PG8_WAIT_L
#undef PG8_BAR
#undef PG8_SCHED
#undef PG8_APTR
#undef PG8_BPTR
}
}

#define XB_TMO      128
#define XB_XCNT(j)  (256  + 64 * (j))
#define XB_XSUB(j)  (1280 + 64 * (j))
#define XB_XGEN(j)  (2304 + 64 * (j))
#define XB_TOP      3328
#define XB_TOPGEN   3392
#define XCD_BAR_WORDS 3456
#define XB_SPIN_CAP (1u << 22)
__device__ __forceinline__ unsigned xb_ld(unsigned* p)              { return __hip_atomic_load(p, __ATOMIC_RELAXED, __HIP_MEMORY_SCOPE_AGENT); }
__device__ __forceinline__ unsigned xb_add(unsigned* p, unsigned v) { return __hip_atomic_fetch_add(p, v, __ATOMIC_RELAXED, __HIP_MEMORY_SCOPE_AGENT); }
__device__ __forceinline__ unsigned xb_xcc_id() { return (unsigned)__builtin_amdgcn_s_getreg((3 << 11) | 20) & 0xFu; }
#define XB_SPIN(cond, bar) do { unsigned _sp = 0; while (cond) { __builtin_amdgcn_s_sleep(1); \
    if ((++_sp & 255u) == 0u) { if (xb_ld(&(bar)[XB_TMO])) break; if (_sp > XB_SPIN_CAP) { atomicAdd(&(bar)[XB_TMO], 1u); break; } } } } while (0)
struct XcdBarrier { unsigned* bar; unsigned x; volatile LAS unsigned* st; };
__device__ __forceinline__ XcdBarrier xcd_barrier_post(unsigned* bar, volatile LAS unsigned* st, bool leader) {
    XcdBarrier b; b.bar = bar; b.x = xb_xcc_id(); b.st = st;
    if (leader) (void)xb_add(&bar[XB_XCNT(b.x)], 1u);
    return b;
}
__device__ __forceinline__ void xcd_barrier_complete(unsigned* bar, unsigned x, unsigned& nloc, unsigned& nx) {
    const unsigned G = gridDim.x * gridDim.y * gridDim.z;
    unsigned sum, cnt, mine, sp = 0u;
    for (;;) {
        sum = 0u; cnt = 0u; mine = 0u;
#pragma unroll
        for (unsigned j = 0; j < 16; ++j) { const unsigned c = xb_ld(&bar[XB_XCNT(j)]); sum += c; cnt += (c > 0u) ? 1u : 0u; mine = (j == x) ? c : mine; }
        if (sum == G) break;
        __builtin_amdgcn_s_sleep(1);
        if ((++sp & 255u) == 0u) { if (xb_ld(&bar[XB_TMO])) break; if (sp > XB_SPIN_CAP) { atomicAdd(&bar[XB_TMO], 1u); break; } }
    }
    nloc = mine > 0u ? mine : 1u; nx = cnt > 0u ? cnt : 1u;
}
__device__ __forceinline__ void xcd_barrier(const XcdBarrier& b, bool leader) {
    asm volatile("s_waitcnt vmcnt(0)" ::: "memory");
    __syncthreads();
    if (leader) {
        GAS unsigned* barg = (GAS unsigned*)b.bar; asm volatile("" : "+s"(barg)); unsigned* bar = (unsigned*)barg;
        __builtin_amdgcn_s_waitcnt(0);
        unsigned nloc = b.st[0], nx = b.st[1];
        if (nloc == 0u) { xcd_barrier_complete(bar, b.x, nloc, nx); b.st[0] = nloc; b.st[1] = nx; }
        const unsigned old = xb_add(&bar[XB_XSUB(b.x)], 1u);
        const unsigned gen = old / nloc;
        if (old + 1u == (gen + 1u) * nloc) {
            __builtin_amdgcn_fence(__ATOMIC_RELEASE, "agent");
            asm volatile("s_waitcnt vmcnt(0)" ::: "memory");
            const unsigned og = xb_add(&bar[XB_TOP], 1u);
            const unsigned tg = og / nx;
            if (og + 1u == (tg + 1u) * nx) xb_add(&bar[XB_TOPGEN], 1u);
            else XB_SPIN(xb_ld(&bar[XB_TOPGEN]) == tg, bar);
            __builtin_amdgcn_fence(__ATOMIC_ACQUIRE, "agent");
            xb_add(&bar[XB_XGEN(b.x)], 1u);
            asm volatile("s_waitcnt vmcnt(0)" ::: "memory");
        } else {
            XB_SPIN(xb_ld(&bar[XB_XGEN(b.x)]) == gen, bar);
            __builtin_amdgcn_fence(__ATOMIC_ACQUIRE, "agent");
            asm volatile("s_waitcnt vmcnt(0)" ::: "memory");
        }
    }
    __syncthreads();
}

struct Args { const float* in[24]; float* out; unsigned char* ws; int ph_lo, ph_hi; };
enum { I_X = 0, I_P, I_LNG, I_WIN, I_BIN, I_CONVW, I_CONVB, I_WA, I_BA, I_WX, I_BX, I_LAM, I_CW1, I_CW2, I_CPOS, I_NQG, I_NKG, I_FQG, I_FKG, I_WBR, I_WOUT, I_WPLE, I_PLEG, I_WPG };

#define CAS __attribute__((address_space(4)))
struct ArgsG { const GAS float* in[24]; GAS float* out; GAS unsigned char* ws; int ph_lo, ph_hi; };
static_assert(sizeof(ArgsG) == sizeof(Args), "ArgsG mirrors Args");
struct Frame {
    LAS unsigned char* lds;
    int wave, G, vcu;
    const CAS ArgsG* A;
    GAS float* out_g; GAS unsigned char* ws_g;
    float* out; unsigned char* ws;
};
__device__ __forceinline__ Frame pin(const Frame& f) { Frame g = f; asm volatile("" : "+s"(g.ws_g), "+s"(g.out_g), "+s"(g.A), "+s"(g.wave), "+s"(g.vcu)); g.ws = (unsigned char*)g.ws_g; g.out = (float*)g.out_g; return g; }
#define INP(k) ((const float*)F.A->in[k])
#define PHASE_IDS() const int lane = lane_id(); const int tid = F.wave * 64 + lane; (void)tid; (void)lane
struct LayerW { bf16 *Win, *Wbr, *Wout, *Wgate, *Wple, *Wc1, *gw, *w2t; float *bias, *posb, *posp, *sw, *sg, *so; };
__device__ __forceinline__ LayerW layer_w(unsigned char* ws, int l) {
    unsigned char* b = ws + WS_W + (size_t)l * WL_STRIDE; LayerW w;
    w.Win = (bf16*)(b + WL_IN); w.Wbr = (bf16*)(b + WL_BR); w.Wout = (bf16*)(b + WL_OUT); w.Wgate = (bf16*)(b + WL_GATE); w.Wple = (bf16*)(b + WL_PLE); w.Wc1 = (bf16*)(b + WL_C1);
    w.bias = (float*)(b + WL_MISC + WM_BIAS); w.posb = (float*)(b + WL_MISC + WM_POSB); w.posp = (float*)(b + WL_MISC + WM_POSP); w.gw = (bf16*)(b + WL_MISC + WM_GW); w.w2t = (bf16*)(b + WL_MISC + WM_W2T); w.sw = (float*)(b + WL_MISC + WM_SW); w.sg = (float*)(b + WL_MISC + WM_SG); w.so = (float*)(b + WL_MISC + WM_SO); return w;
}
#define ZP(off) ((bf16*)(F.ws + WS_Z + (off)))

template <bool REMAP>
__device__ __forceinline__ void transpose_item(const float* W, int K, int N, bf16* WT, LAS float* scr, int item, int lane, const float* kscale = nullptr) {
    const int nblk = N / 32, kb = item / nblk, nb = item % nblk, k0 = 64 * kb, n0 = 32 * nb;
#pragma unroll 8
    for (int i = 0; i < 32; ++i) { const int kk = 2 * i + (lane >> 5); float w = W[(size_t)(k0 + kk) * N + n0 + (lane & 31)]; if (REMAP) w *= kscale[k0 + kk]; scr[kk * 33 + (lane & 31)] = w; }
    LDS_WAIT(); asm volatile("" ::: "memory");
    const int c = lane & 7;
#pragma unroll
    for (int j = 0; j < 4; ++j) { const int n = (lane >> 3) + 8 * j; const LAS float* s = scr + (8 * c) * 33 + n;
        const int nn = REMAP ? nmap(n0 + n) : (n0 + n);
        { u32x4 o; o.x = pk2(s[0 * 33], s[1 * 33]); o.y = pk2(s[2 * 33], s[3 * 33]); o.z = pk2(s[4 * 33], s[5 * 33]); o.w = pk2(s[6 * 33], s[7 * 33]);
            *(u32x4*)(WT + (size_t)nn * K + k0 + 8 * c) = o; } }
    LDS_WAIT(); asm volatile("" ::: "memory");
}
__device__ __forceinline__ void fuseq_item(const Frame& F, int tid, int lane, const float* W, int N, int n0, const float* kscale, bf16* WT, float* scales, bool remap) {
    constexpr int PITCH = 4112;
    LAS unsigned char* img = F.lds;
    __syncthreads();
    const int c = tid & 31, k0 = tid >> 5;
#pragma unroll 1
    for (int ib = 0; ib < 128; ib += 16) { float v[16];
#pragma unroll
        for (int j = 0; j < 16; ++j) v[j] = W[(size_t)(k0 + 16 * (ib + j)) * N + n0 + c];
#pragma unroll
        for (int j = 0; j < 16; ++j) { const int k = k0 + 16 * (ib + j); float w = v[j]; if (kscale) w *= kscale[k];
            *(LAS unsigned short*)(img + c * PITCH + k * 2) = (unsigned short)f2bf(w); } }
    __syncthreads();
    const int wv = tid >> 6;
#pragma unroll 1
    for (int q = 0; q < 4; ++q) { const int cc = wv * 4 + q, n = n0 + cc, nn = remap ? nmap(n) : n;
        const LAS u32x4* src = (const LAS u32x4*)(img + cc * PITCH);
        u32x4 v[4]; float mx = 0.f;
#pragma unroll
        for (int j = 0; j < 4; ++j) { v[j] = src[64 * j + lane];
            mx = fmaxf(mx, fmaxf(fmaxf(fabsf(bf_lo(v[j].x)), fabsf(bf_hi(v[j].x))), fmaxf(fabsf(bf_lo(v[j].y)), fabsf(bf_hi(v[j].y)))));
            mx = fmaxf(mx, fmaxf(fmaxf(fabsf(bf_lo(v[j].z)), fabsf(bf_hi(v[j].z))), fmaxf(fabsf(bf_lo(v[j].w)), fabsf(bf_hi(v[j].w))))); }
        bf16* dst = WT + (size_t)nn * DM;
        if (remap && nn >= NIN - 32) {
#pragma unroll
            for (int j = 0; j < 4; ++j) ((u32x4*)dst)[64 * j + lane] = v[j];
            continue; }
        mx = fmaxf(mx, xlane<1>(mx)); mx = fmaxf(mx, xlane<2>(mx)); mx = fmaxf(mx, xlane<4>(mx)); mx = fmaxf(mx, xlane<8>(mx)); mx = fmaxf(mx, xlane<16>(mx));
        { auto rr = __builtin_amdgcn_permlane32_swap(__float_as_uint(mx), __float_as_uint(mx), false, false); mx = fmaxf(__uint_as_float(rr[0]), __uint_as_float(rr[1])); }
        const float sc = mx > 0.f ? mx * (1.0f / 127.0f) : 1.0f, inv = 1.0f / sc;
#pragma unroll
        for (int j = 0; j < 4; ++j) { u32x2 o;
            o.x = pk4_i8(rintf(bf_lo(v[j].x) * inv), rintf(bf_hi(v[j].x) * inv), rintf(bf_lo(v[j].y) * inv), rintf(bf_hi(v[j].y) * inv));
            o.y = pk4_i8(rintf(bf_lo(v[j].z) * inv), rintf(bf_hi(v[j].z) * inv), rintf(bf_lo(v[j].w) * inv), rintf(bf_hi(v[j].w) * inv));
            ((u32x2*)dst)[64 * j + lane] = o; }
        if (lane == 0) scales[nn] = sc; }
}
__device__ __forceinline__ void phase_prologue(const Frame& F0) {
    const Frame F = pin(F0); PHASE_IDS();
    LAS float* scr = (LAS float*)(F.lds + F.wave * 16384);
    const int gw = F.vcu * NWAVES + F.wave, NGW = F.G * NWAVES;
    constexpr int I_IN = (DM / 64) * (NIN / 32), I_BR = (BW / 64) * (DM / 32), I_SQ = (DM / 64) * (DM / 32), I_PL = (PLE / 64) * (DM / 32), I_C1 = (4096 / 64) * (CMPH / 32);
    constexpr int PER_LAYER = I_IN + 3 * I_BR + 2 * I_SQ + I_PL + 2 * I_C1;
    for (int it = gw; it < DEPTH * PER_LAYER; it += NGW) {
        const int l = it / PER_LAYER; int r = it - l * PER_LAYER; const LayerW w = layer_w(F.ws, l);
        if (r < I_IN) { if (!P0_FUSEQ) transpose_item<true>(INP(I_WIN) + (size_t)l * DM * NIN, DM, NIN, w.Win, scr, r, lane, INP(I_LNG) + (size_t)l * DM); continue; } r -= I_IN;
        if (r < 3 * I_BR) { const int i = r / I_BR; transpose_item<false>(INP(I_WBR) + ((size_t)l * 3 + i) * BW * DM, BW, DM, w.Wbr + (size_t)i * DM * BW, scr, r - i * I_BR, lane); continue; } r -= 3 * I_BR;
        if (r < I_SQ) { if (!(P0_FUSEQ && I8_P6)) transpose_item<false>(INP(I_WOUT) + (size_t)l * DM * DM, DM, DM, w.Wout, scr, r, lane); continue; } r -= I_SQ;
        if (r < I_SQ) { if (!(P0_FUSEQ && I8_P7)) transpose_item<false>(INP(I_WPG) + (size_t)l * DM * DM, DM, DM, w.Wgate, scr, r, lane); continue; } r -= I_SQ;
        if (r < I_PL) { transpose_item<false>(INP(I_WPLE) + (size_t)l * PLE * DM, PLE, DM, w.Wple, scr, r, lane); continue; } r -= I_PL;
        { const int j = r / I_C1; transpose_item<false>(INP(I_CW1) + ((size_t)l * 2 + j) * 4096 * CMPH, 4096, CMPH, w.Wc1 + (size_t)j * CMPH * 4096, scr, r - j * I_C1, lane); }
    }
    const int gt = F.vcu * NTHREADS + tid, NGT = F.G * NTHREADS;
    for (int l = 0; l < DEPTH; ++l) {
        const LayerW w = layer_w(F.ws, l);
        u32x4* z = (u32x4*)(w.Win + (size_t)NIN * DM);
        for (int i = gt; i < (NINP - NIN) * DM / 8; i += NGT) z[i] = (u32x4){0u, 0u, 0u, 0u};
        for (int i = gt; i < NINP; i += NGT) if (i >= NIN) w.bias[i] = 0.f;
        for (int i = gt; i < NIN; i += NGT) w.bias[nmap(i)] = INP(I_BIN)[(size_t)l * NIN + i];
    }
    { bf16* hb = (bf16*)(F.ws + WS_X2); float* PS = (float*)(F.ws + WS_PS); const float* x = INP(I_X);
      unsigned char* a8 = F.ws + WS_A8; float* sa = (float*)(F.ws + WS_RSE);
      for (int m = gw; m < T; m += NGW) { const f32x4* xr = (const f32x4*)(x + (size_t)m * DM) + lane; u32x2* o = (u32x2*)(hb + (size_t)m * DM) + lane; float ssq = 0.f, mx = 0.f;
          u32x2 wb[8];
#pragma unroll
          for (int j = 0; j < 8; ++j) { const f32x4 v = xr[64 * j]; ssq += (v.x * v.x + v.y * v.y) + (v.z * v.z + v.w * v.w); u32x2 w; w.x = pk2(v.x, v.y); w.y = pk2(v.z, v.w); o[64 * j] = w; wb[j] = w;
              mx = fmaxf(mx, fmaxf(fmaxf(fabsf(bf_lo(w.x)), fabsf(bf_hi(w.x))), fmaxf(fabsf(bf_lo(w.y)), fabsf(bf_hi(w.y))))); }
          ssq = wave_sum(ssq); if (lane < 8) PS[(size_t)m * 8 + lane] = lane == 0 ? ssq : 0.f;
          mx = fmaxf(mx, xlane<1>(mx)); mx = fmaxf(mx, xlane<2>(mx)); mx = fmaxf(mx, xlane<4>(mx)); mx = fmaxf(mx, xlane<8>(mx)); mx = fmaxf(mx, xlane<16>(mx));
          { auto rr = __builtin_amdgcn_permlane32_swap(__float_as_uint(mx), __float_as_uint(mx), false, false); mx = fmaxf(__uint_as_float(rr[0]), __uint_as_float(rr[1])); }
          const float sc = mx > 0.f ? mx * (1.0f / 127.0f) : 1.0f, inv = 1.0f / sc;
          unsigned* o8 = (unsigned*)(a8 + (size_t)m * DM) + lane;
#pragma unroll
          for (int j = 0; j < 8; ++j) o8[64 * j] = pk4_i8(rintf(bf_lo(wb[j].x) * inv), rintf(bf_hi(wb[j].x) * inv), rintf(bf_lo(wb[j].y) * inv), rintf(bf_hi(wb[j].y) * inv));
          if (lane == 0) sa[m] = sc; } }
    { const f32x4* p4 = (const f32x4*)INP(I_P); u32x2* o = (u32x2*)(F.ws + WS_PB);
      for (size_t i = gt; i < (size_t)DEPTH * T * PLE / 4; i += NGT) { const f32x4 v = p4[i]; u32x2 w; w.x = pk2(v.x, v.y); w.y = pk2(v.z, v.w); o[i] = w; } }
    for (int l = 0; l < DEPTH; ++l) { const LayerW w = layer_w(F.ws, l);
        for (int i = gt; i < 2 * 128 * 256; i += NGT) { const int j = i >> 15, d = (i >> 8) & 127, k = i & 255;
            w.w2t[i] = (bf16)f2bf(INP(I_CW2)[(((size_t)l * 2 + j) * CMPH + k) * HD + d]); } }
    for (int l = 0; l < DEPTH; ++l) { const LayerW w = layer_w(F.ws, l);
        for (int i = gt; i < 2 * 16 * 4096; i += NGT) { const int mtx = i >> 16, n = (i >> 12) & 15, j = (i >> 6) & 63, k = i & 63;
            w.gw[i] = (bf16)f2bf((mtx ? INP(I_WX) : INP(I_WA))[((size_t)l * 16 + n) * 4096 + k * 64 + j]); } }
    for (int it = gw; it < DEPTH * 2 * 16 * 4; it += NGW) {
        const int q = it & 3, c = (it >> 2) & 15, j = (it >> 6) & 1, l = it >> 7; const LayerW w = layer_w(F.ws, l);
        const float* pos = INP(I_CPOS) + ((size_t)l * 2 + j) * 4096 + c * 256;
        const float* w1 = INP(I_CW1) + (((size_t)l * 2 + j) * 4096 + c * 256) * CMPH + q * 64 + lane;
        float s = 0.f;
#pragma unroll 8
        for (int i = 0; i < 256; ++i) s += pos[i] * w1[(size_t)i * CMPH];
        w.posp[(j * 16 + c) * 256 + q * 64 + lane] = s;
    }
    if (P0_FUSEQ) {
        constexpr int NI_IN = NIN / 32, NI_SQ = DM / 32, PER = NI_IN + (I8_P6 ? NI_SQ : 0) + (I8_P7 ? NI_SQ : 0);
        static_assert(NIN % 32 == 0, "whole 32-column items");
        for (int it = F.vcu; it < DEPTH * PER; it += F.G) { const int l = it / PER; int r = it - l * PER; const LayerW w = layer_w(F.ws, l);
            if (r < NI_IN) { fuseq_item(F, tid, lane, INP(I_WIN) + (size_t)l * DM * NIN, NIN, r * 32, INP(I_LNG) + (size_t)l * DM, w.Win, w.sw, true); continue; } r -= NI_IN;
            if (I8_P6 && r < NI_SQ) { fuseq_item(F, tid, lane, INP(I_WOUT) + (size_t)l * DM * DM, DM, r * 32, nullptr, w.Wout, w.so, false); continue; } if (I8_P6) r -= NI_SQ;
            fuseq_item(F, tid, lane, INP(I_WPG) + (size_t)l * DM * DM, DM, r * 32, nullptr, w.Wgate, w.sg, false); }
    }
}


__device__ __forceinline__ float quant_row(const bf16* src, unsigned char* dst, int lane) {
    u32x4 v[4]; float mx = 0.f;
#pragma unroll
    for (int j = 0; j < 4; ++j) { v[j] = ((const u32x4*)src)[64 * j + lane];
        mx = fmaxf(mx, fmaxf(fmaxf(fabsf(bf_lo(v[j].x)), fabsf(bf_hi(v[j].x))), fmaxf(fabsf(bf_lo(v[j].y)), fabsf(bf_hi(v[j].y)))));
        mx = fmaxf(mx, fmaxf(fmaxf(fabsf(bf_lo(v[j].z)), fabsf(bf_hi(v[j].z))), fmaxf(fabsf(bf_lo(v[j].w)), fabsf(bf_hi(v[j].w))))); }
    mx = fmaxf(mx, xlane<1>(mx)); mx = fmaxf(mx, xlane<2>(mx)); mx = fmaxf(mx, xlane<4>(mx)); mx = fmaxf(mx, xlane<8>(mx)); mx = fmaxf(mx, xlane<16>(mx));
    { auto rr = __builtin_amdgcn_permlane32_swap(__float_as_uint(mx), __float_as_uint(mx), false, false); mx = fmaxf(__uint_as_float(rr[0]), __uint_as_float(rr[1])); }
    const float sc = mx > 0.f ? mx * (1.0f / 127.0f) : 1.0f, inv = 1.0f / sc;
    asm volatile("" ::: "memory");
#pragma unroll
    for (int j = 0; j < 4; ++j) { u32x2 o;
        o.x = pk4_i8(rintf(bf_lo(v[j].x) * inv), rintf(bf_hi(v[j].x) * inv), rintf(bf_lo(v[j].y) * inv), rintf(bf_hi(v[j].y) * inv));
        o.y = pk4_i8(rintf(bf_lo(v[j].z) * inv), rintf(bf_hi(v[j].z) * inv), rintf(bf_lo(v[j].w) * inv), rintf(bf_hi(v[j].w) * inv));
        ((u32x2*)dst)[64 * j + lane] = o; }
    return sc;
}
__device__ __forceinline__ void phase_quant_w(const Frame& F0) {
    const Frame F = pin(F0); PHASE_IDS();
    const int gw = F.vcu * NWAVES + F.wave, NGW = F.G * NWAVES;
    for (int it = gw; it < DEPTH * (NIN - 32); it += NGW) { const int l = it / (NIN - 32), n = it - l * (NIN - 32); const LayerW w = layer_w(F.ws, l);
        const float sc = quant_row(w.Win + (size_t)n * DM, (unsigned char*)(w.Win + (size_t)n * DM), lane); if (lane == 0) w.sw[n] = sc; }
    if (I8_P7) for (int it = gw; it < DEPTH * DM; it += NGW) { const int l = it / DM, n = it - l * DM; const LayerW w = layer_w(F.ws, l);
        const float sc = quant_row(w.Wgate + (size_t)n * DM, (unsigned char*)(w.Wgate + (size_t)n * DM), lane); if (lane == 0) w.sg[n] = sc; }
    if (I8_P6) for (int it = gw; it < DEPTH * DM; it += NGW) { const int l = it / DM, n = it - l * DM; const LayerW w = layer_w(F.ws, l);
        const float sc = quant_row(w.Wout + (size_t)n * DM, (unsigned char*)(w.Wout + (size_t)n * DM), lane); if (lane == 0) w.so[n] = sc; }
}
__device__ __forceinline__ void phase_quant_a(const Frame& F0, size_t src_off = WS_X2, size_t dst_off = WS_A8, size_t sc_off = WS_RSE) {
    const Frame F = pin(F0); PHASE_IDS();
    const int gw = F.vcu * NWAVES + F.wave, NGW = F.G * NWAVES;
    const bf16* hb = (const bf16*)(F.ws + src_off); unsigned char* a8 = F.ws + dst_off; float* sa = (float*)(F.ws + sc_off);
    for (int m = gw; m < T; m += 2 * NGW) {
        const int m1 = m + NGW;
        u32x4 v[2][4]; float mx[2];
#pragma unroll
        for (int q = 0; q < 2; ++q)
#pragma unroll
            for (int j = 0; j < 4; ++j) v[q][j] = ((const u32x4*)(hb + (size_t)(q ? m1 : m) * DM))[64 * j + lane];
#pragma unroll
        for (int q = 0; q < 2; ++q) { float x = 0.f;
#pragma unroll
            for (int j = 0; j < 4; ++j) { x = fmaxf(x, fmaxf(fmaxf(fabsf(bf_lo(v[q][j].x)), fabsf(bf_hi(v[q][j].x))), fmaxf(fabsf(bf_lo(v[q][j].y)), fabsf(bf_hi(v[q][j].y)))));
                x = fmaxf(x, fmaxf(fmaxf(fabsf(bf_lo(v[q][j].z)), fabsf(bf_hi(v[q][j].z))), fmaxf(fabsf(bf_lo(v[q][j].w)), fabsf(bf_hi(v[q][j].w))))); }
            x = fmaxf(x, xlane<1>(x)); x = fmaxf(x, xlane<2>(x)); x = fmaxf(x, xlane<4>(x)); x = fmaxf(x, xlane<8>(x)); x = fmaxf(x, xlane<16>(x));
            { auto rr = __builtin_amdgcn_permlane32_swap(__float_as_uint(x), __float_as_uint(x), false, false); x = fmaxf(__uint_as_float(rr[0]), __uint_as_float(rr[1])); }
            mx[q] = x; }
#pragma unroll
        for (int q = 0; q < 2; ++q) { const float sc = mx[q] > 0.f ? mx[q] * (1.0f / 127.0f) : 1.0f, inv = 1.0f / sc; const int mq = q ? m1 : m;
#pragma unroll
            for (int j = 0; j < 4; ++j) { u32x2 o;
                o.x = pk4_i8(rintf(bf_lo(v[q][j].x) * inv), rintf(bf_hi(v[q][j].x) * inv), rintf(bf_lo(v[q][j].y) * inv), rintf(bf_hi(v[q][j].y) * inv));
                o.y = pk4_i8(rintf(bf_lo(v[q][j].z) * inv), rintf(bf_hi(v[q][j].z) * inv), rintf(bf_lo(v[q][j].w) * inv), rintf(bf_hi(v[q][j].w) * inv));
                ((u32x2*)(a8 + (size_t)mq * DM))[64 * j + lane] = o; }
            if (lane == 0) sa[mq] = sc; }
    }
}
struct Dst { bf16* base; int pitch; long bjs; int act; const float* gain; };
enum { ACT_NONE = 0, ACT_SILU = 1, ACT_NORM = 2, ACT_EXPG = 3, ACT_SIGU8 = 4 };

__device__ __forceinline__ void store_tile(pg8::Acc& acc, const Dst& d, LAS float* red, int wr, int wc, int fr, int fq) {
    if (d.act == ACT_NORM) {
#pragma unroll
        for (int ai = 0; ai < 2; ++ai)
#pragma unroll
            for (int m = 0; m < 4; ++m)
#pragma unroll
                for (int bj = 0; bj < 2; ++bj) { const f32x4 a = acc[ai][bj][m][0], b = acc[ai][bj][m][1];
                    float s = (a.x * a.x + a.y * a.y) + (a.z * a.z + a.w * a.w) + (b.x * b.x + b.y * b.y) + (b.z * b.z + b.w * b.w);
                    s += xlane<16>(s); s = xsum32(s);
                    if (fq == 0) red[((ai * 128 + wr * 64 + m * 16 + fr) * 2 + bj) * 4 + wc] = s; }
        LDS_WAIT(); __builtin_amdgcn_s_barrier(); asm volatile("" ::: "memory");
    }
    f32x4 g0 = (f32x4){1.f, 1.f, 1.f, 1.f}, g1 = g0;
    if (d.act == ACT_NORM) { g0 = *(const f32x4*)(d.gain + wc * 32 + 8 * fq); g1 = *(const f32x4*)(d.gain + wc * 32 + 8 * fq + 4); }
#pragma unroll
    for (int ai = 0; ai < 2; ++ai)
#pragma unroll
        for (int m = 0; m < 4; ++m) { int rr = ai * 128 + wr * 64 + m * 16 + fr; asm volatile("" : "+v"(rr));
#pragma unroll
            for (int bj = 0; bj < 2; ++bj) { f32x4 v0 = acc[ai][bj][m][0], v1 = acc[ai][bj][m][1];
                if (d.act == ACT_NORM) { const f32x4 r4 = *(const LAS f32x4*)(red + (rr * 2 + bj) * 4);
                    const float rstd = 1.0f / sqrtf(((r4.x + r4.y) + (r4.z + r4.w)) * (1.f / HD) + EPS); v0 = v0 * rstd * g0; v1 = v1 * rstd * g1; }
                if (d.act == ACT_SILU) {
#pragma unroll
                    for (int i = 0; i < 4; ++i) { v0[i] = v0[i] * sigmoidf_(v0[i]); v1[i] = v1[i] * sigmoidf_(v1[i]); } }
                if (d.act == ACT_EXPG) {
#pragma unroll
                    for (int i = 0; i < 4; ++i) { v0[i] = 1.0f + __builtin_amdgcn_exp2f(-1.4426950408889634f * fminf(fmaxf(v0[i], -30.f), 30.f)); v1[i] = 1.0f + __builtin_amdgcn_exp2f(-1.4426950408889634f * fminf(fmaxf(v1[i], -30.f), 30.f)); } }
                if (d.act == ACT_SIGU8) {
                    unsigned q[2] = {0u, 0u};
#pragma unroll
                    for (int i = 0; i < 4; ++i) { const float m0 = __builtin_amdgcn_rcpf(1.0f + __builtin_amdgcn_exp2f(-1.4426950408889634f * v0[i])), m1 = __builtin_amdgcn_rcpf(1.0f + __builtin_amdgcn_exp2f(-1.4426950408889634f * v1[i]));
                        const unsigned u0 = (unsigned)fmaxf(m0 * 255.0f + 0.5f, 1.0f), u1 = (unsigned)fmaxf(m1 * 255.0f + 0.5f, 1.0f);
                        q[0] |= u0 << (8 * i); q[1] |= u1 << (8 * i); }
                    u32x2 w8; w8.x = q[0]; w8.y = q[1];
                    *(u32x2*)((unsigned char*)d.base + bj * d.bjs + (size_t)rr * d.pitch + wc * 32 + 8 * fq) = w8;
                    continue; }
                u32x4 w; w.x = cvt_pk_bf16(v0[0], v0[1]); w.y = cvt_pk_bf16(v0[2], v0[3]); w.z = cvt_pk_bf16(v1[0], v1[1]); w.w = cvt_pk_bf16(v1[2], v1[3]);
                *(u32x4*)(d.base + bj * d.bjs + (size_t)rr * d.pitch + wc * 32 + 8 * fq) = w; }
            asm volatile("" ::: "memory"); }
}
__device__ __forceinline__ void add_bias(pg8::Acc& acc, const float* bias, int col0) {
#pragma unroll
    for (int bj = 0; bj < 2; ++bj)
#pragma unroll
        for (int n = 0; n < 2; ++n) { const f32x4 bv = *(const f32x4*)(bias + col0 + bj * 128 + 4 * n);
#pragma unroll
            for (int ai = 0; ai < 2; ++ai)
#pragma unroll
                for (int m = 0; m < 4; ++m) acc[ai][bj][m][n] += bv; }
}

struct EpiIn {
    static constexpr bool AFTER_DRAIN = false;
    unsigned char* ws; const float* bias; const float *g_nq, *g_nk, *g_fq, *g_fk; LAS float* red; const float* PS; int* cur_pm; bool plain; int pn0; float wscale; const float* SA; const float* SW; bool i8;
    __device__ __forceinline__ void operator()(pg8::Acc& acc, const pg8::Unit& u, int wr, int wc, int fr, int fq) const {
        if (i8) {
#pragma unroll
            for (int ai = 0; ai < 2; ++ai)
#pragma unroll
                for (int bj = 0; bj < 2; ++bj)
#pragma unroll
                    for (int m = 0; m < 4; ++m)
#pragma unroll
                        for (int n = 0; n < 2; ++n) { const f32x4 a = acc[ai][bj][m][n];
                            acc[ai][bj][m][n] = (f32x4){(float)__float_as_int(a.x), (float)__float_as_int(a.y), (float)__float_as_int(a.z), (float)__float_as_int(a.w)}; } }
        LAS float* rsl = red + 2048;
        if (u.pm != *cur_pm) { *cur_pm = u.pm;
            const int t2 = (wr * 4 + wc) * 64 + fq * 16 + fr;
            if (t2 < 256) { const float* pp = PS + ((size_t)u.pm * 256 + t2) * 8; const f32x4 q0 = *(const f32x4*)pp, q1 = *(const f32x4*)(pp + 4);
                rsl[t2] = SA[(size_t)u.pm * 256 + t2] / sqrtf((((q0.x + q0.y) + (q0.z + q0.w)) + ((q1.x + q1.y) + (q1.z + q1.w))) * (1.f / DM) + EPS); }
            LDS_WAIT(); __builtin_amdgcn_s_barrier(); asm volatile("" ::: "memory"); }
#pragma unroll
        for (int ai = 0; ai < 2; ++ai)
#pragma unroll
            for (int m = 0; m < 4; ++m) { const float rs = rsl[ai * 128 + wr * 64 + m * 16 + fr] * wscale;
#pragma unroll
                for (int bj = 0; bj < 2; ++bj) { acc[ai][bj][m][0] *= rs; acc[ai][bj][m][1] *= rs; } }
        const int pn = u.pn + pn0, b = u.pm >> 4, s0 = (u.pm & 15) * 256;
#pragma unroll
        for (int bj = 0; bj < 2; ++bj) { const f32x4 c0 = *(const f32x4*)(SW + pn * 256 + bj * 128 + wc * 32 + 8 * fq), c1 = *(const f32x4*)(SW + pn * 256 + bj * 128 + wc * 32 + 8 * fq + 4);
#pragma unroll
            for (int ai = 0; ai < 2; ++ai)
#pragma unroll
                for (int m = 0; m < 4; ++m) { acc[ai][bj][m][0] *= c0; acc[ai][bj][m][1] *= c1; } }
        add_bias(acc, bias, pn * 256 + wc * 32 + 8 * fq);
        if (pn == 62) {
            if (wc == 0) { float* BG = (float*)(ws + WS_Z + Z_BG); float* LF = (float*)(ws + WS_Z + Z_LF);
#pragma unroll
                for (int ai = 0; ai < 2; ++ai)
#pragma unroll
                    for (int m = 0; m < 4; ++m) { const size_t row = (size_t)u.pm * 256 + ai * 128 + wr * 64 + m * 16 + fr;
#pragma unroll
                        for (int n = 0; n < 2; ++n)
#pragma unroll
                            for (int i = 0; i < 4; ++i) { const int col = 8 * fq + 4 * n + i; const float v = acc[ai][0][m][n][i];
                                if (col < 24) BG[row * 24 + col] = sigmoidf_(v);
                                else LF[row * 8 + (col - 24)] = (v >= 0.f) ? -log1pf(__expf(-v)) : (v - log1pf(__expf(v))); } } }
            pg8::zero_acc(acc); return;
        }
        Dst d; d.gain = nullptr; d.act = ACT_NONE;
#define TM(off, W_, ct) do { d.base = (bf16*)(ws + WS_Z + (off)) + (size_t)u.pm * 256 * (W_) + (ct) * 256; d.pitch = (W_); d.bjs = 128; } while (0)
#define HM(off, NH_, h0) do { d.base = (bf16*)(ws + WS_Z + (off)) + ((size_t)(b * (NH_) + (h0)) * SEQ + s0) * HD; d.pitch = HD; d.bjs = (long)SEQ * HD; } while (0)
        if (pn < 4) { TM(Z_U, BW, pn); }
        else if (pn < 8) { TM(Z_GA, BW, pn - 4); d.act = ACT_SILU; }
        else if (pn < 12) { HM(Z_QN, 8, (pn - 8) * 2); d.act = ACT_NORM; d.gain = g_nq; }
        else if (pn == 12) { HM(Z_KC, 2, 0); }
        else if (pn == 13) { HM(Z_VC, 2, 0); }
        else if (pn == 14) { HM(Z_KS, 2, 0); d.act = ACT_NORM; d.gain = g_nk; }
        else if (pn == 15) { HM(Z_VS, 2, 0); }
        else if (pn == 16) { HM(Z_KW, 2, 0); d.act = ACT_NORM; d.gain = g_nk; }
        else if (pn == 17) { HM(Z_VW, 2, 0); }
        else if (pn < 22) { TM(Z_GB, BW, pn - 18); d.act = ACT_SILU; }
        else if (pn < 26) { HM(Z_QF, 8, (pn - 22) * 2); d.act = ACT_NORM; d.gain = g_fq; }
        else if (pn < 30) { HM(Z_KF, 8, (pn - 26) * 2); d.act = ACT_NORM; d.gain = g_fk; }
        else if (pn < 34) { HM(Z_VF, 8, (pn - 30) * 2); }
        else if (pn < 38) { TM(Z_GC, BW, pn - 34); d.act = ACT_SILU; }
        else { d.base = (bf16*)(ws + WS_Z + Z_MG + (size_t)u.pm * 256 * (3 * DM) + (size_t)(pn - 38) * 256); d.pitch = 3 * DM; d.bjs = 128; d.act = ACT_SIGU8; }
#undef TM
#undef HM
        if (plain) d.act = ACT_NONE;
        store_tile(acc, d, red, wr, wc, fr, fq);
        pg8::zero_acc(acc);
    }
};
struct EpiStore {
    static constexpr bool AFTER_DRAIN = false;
    bf16* O0; bf16* O1; int ldc; const float* bias0; const float* bias1; int act;
    __device__ __forceinline__ void operator()(pg8::Acc& acc, const pg8::Unit& u, int wr, int wc, int fr, int fq) const {
        const float* bias = u.seg ? bias1 : bias0;
        if (bias) add_bias(acc, bias, u.pn * 256 + wc * 32 + 8 * fq);
        Dst d; d.base = (u.seg ? O1 : O0) + (size_t)u.pm * 256 * ldc + u.pn * 256; d.pitch = ldc; d.bjs = 128; d.act = act; d.gain = nullptr;
        store_tile(acc, d, nullptr, wr, wc, fr, fq);
        pg8::zero_acc(acc);
    }
};

struct EpiCmp {
    static constexpr bool AFTER_DRAIN = true;
    const float* posb; const bf16* w2t; const float* gk; bf16* KC; bf16* VC;
    __device__ __forceinline__ void operator()(pg8::Acc&, const pg8::Unit&, int, int, int, int) const {}
    __device__ __forceinline__ void fused(pg8::Acc& acc, const pg8::Unit& u, int wr, int wc, int fr, int fq, LAS unsigned char* lds, int wid, int lane) const {
        typedef float f32x16 __attribute__((ext_vector_type(16)));
        constexpr int HP = 264;
        LAS bf16* hid = (LAS bf16*)lds;
        const int j = u.seg;
        add_bias(acc, posb + j * 256, wc * 32 + 8 * fq);
#pragma unroll
        for (int ai = 0; ai < 2; ++ai)
#pragma unroll
            for (int m = 0; m < 4; ++m) { const int rr = ai * 128 + wr * 64 + m * 16 + fr;
#pragma unroll
                for (int bj = 0; bj < 2; ++bj) { f32x4 v0 = acc[ai][bj][m][0], v1 = acc[ai][bj][m][1];
#pragma unroll
                    for (int i = 0; i < 4; ++i) { v0[i] = v0[i] * sigmoidf_(v0[i]); v1[i] = v1[i] * sigmoidf_(v1[i]); }
                    u32x4 w; w.x = cvt_pk_bf16(v0[0], v0[1]); w.y = cvt_pk_bf16(v0[2], v0[3]); w.z = cvt_pk_bf16(v1[0], v1[1]); w.w = cvt_pk_bf16(v1[2], v1[3]);
                    *(LAS u32x4*)(hid + rr * HP + bj * 128 + wc * 32 + 8 * fq) = w; } }
        LDS_WAIT(); __builtin_amdgcn_s_barrier(); asm volatile("" ::: "memory");
        const int r32 = lane & 31, hi = lane >> 5;
        f32x16 o[4] = {};
        const bf16* wt = w2t + (size_t)j * 128 * 256;
#pragma unroll 4
        for (int ks = 0; ks < 16; ++ks) { const bf16x8 af = *(const LAS bf16x8*)(hid + (wid * 32 + r32) * HP + ks * 16 + hi * 8);
#pragma unroll
            for (int ct = 0; ct < 4; ++ct) { const bf16x8 bfr = *(const bf16x8*)(wt + (size_t)(ct * 32 + r32) * 256 + ks * 16 + hi * 8);
                o[ct] = __builtin_amdgcn_mfma_f32_32x32x16_bf16(af, bfr, o[ct], 0, 0, 0); } }
        float g4[4] = {1.f, 1.f, 1.f, 1.f};
        if (j == 0) {
#pragma unroll
            for (int ct = 0; ct < 4; ++ct) g4[ct] = gk[ct * 32 + r32]; }
        bf16* O = (j ? VC : KC) + ((size_t)u.pm * 256 + wid * 32) * HD + r32;
#pragma unroll
        for (int r = 0; r < 16; ++r) { const int row = (r & 3) + 8 * (r >> 2) + 4 * hi; float sc = 1.f;
            if (j == 0) { float ss = (o[0][r] * o[0][r] + o[1][r] * o[1][r]) + (o[2][r] * o[2][r] + o[3][r] * o[3][r]);
                ss += xlane<1>(ss); ss += xlane<2>(ss); ss += xlane<4>(ss); ss += xlane<8>(ss); ss += xlane<16>(ss);
                sc = 1.0f / sqrtf(ss * (1.f / HD) + EPS); }
            if (wid * 32 + row == 255) sc = 0.f;
#pragma unroll
            for (int ct = 0; ct < 4; ++ct) O[(size_t)row * HD + ct * 32] = (bf16)f2bf(o[ct][r] * sc * g4[ct]); }
    }
};

struct EpiEraw {
    static constexpr bool AFTER_DRAIN = false;
    bf16* O; float* PSE; LAS float* red;
    __device__ __forceinline__ void operator()(pg8::Acc& acc, const pg8::Unit& u, int wr, int wc, int fr, int fq) const {
#pragma unroll
        for (int ai = 0; ai < 2; ++ai)
#pragma unroll
            for (int m = 0; m < 4; ++m) { const int rr = ai * 128 + wr * 64 + m * 16 + fr; float ssq = 0.f;
#pragma unroll
                for (int bj = 0; bj < 2; ++bj) { const f32x4 v0 = acc[ai][bj][m][0], v1 = acc[ai][bj][m][1];
                    ssq += ((v0.x * v0.x + v0.y * v0.y) + (v0.z * v0.z + v0.w * v0.w)) + ((v1.x * v1.x + v1.y * v1.y) + (v1.z * v1.z + v1.w * v1.w));
                    u32x4 w; w.x = cvt_pk_bf16(v0[0], v0[1]); w.y = cvt_pk_bf16(v0[2], v0[3]); w.z = cvt_pk_bf16(v1[0], v1[1]); w.w = cvt_pk_bf16(v1[2], v1[3]);
                    *(u32x4*)(O + ((size_t)u.pm * 256 + rr) * DM + u.pn * 256 + bj * 128 + wc * 32 + 8 * fq) = w; }
                ssq += xlane<16>(ssq); ssq = xsum32(ssq);
                if (fq == 0) red[rr * 4 + wc] = ssq; }
        LDS_WAIT(); __builtin_amdgcn_s_barrier(); asm volatile("" ::: "memory");
        { const int t2 = (wr * 4 + wc) * 64 + fq * 16 + fr;
          if (t2 < 256) { const f32x4 r4 = *(const LAS f32x4*)(red + t2 * 4); PSE[((size_t)u.pm * 256 + t2) * 8 + u.pn] = (r4.x + r4.y) + (r4.z + r4.w); } }
        LDS_WAIT(); __builtin_amdgcn_s_barrier(); asm volatile("" ::: "memory");
        pg8::zero_acc(acc);
    }
};
struct EpiBranch {
    static constexpr bool AFTER_DRAIN = false;
    const unsigned char* MG; bf16* O;
    __device__ __forceinline__ void operator()(pg8::Acc& acc, const pg8::Unit& u, int wr, int wc, int fr, int fq) const {
        const int seg = u.seg;
        const unsigned char* mgp = MG + ((size_t)u.pm * 256 + wr * 64 + fr) * (3 * DM) + seg * DM + u.pn * 256 + wc * 32 + 8 * fq;
        u32x2 ea[2][4][2], eb[2][4][2];
#pragma unroll
        for (int ai = 0; ai < 2; ++ai)
#pragma unroll
            for (int m = 0; m < 4; ++m)
#pragma unroll
                for (int bj = 0; bj < 2; ++bj) { const unsigned char* p = mgp + (size_t)(ai * 128 + m * 16) * (3 * DM) + bj * 128;
                    ea[ai][m][bj] = *(const u32x2*)p;
                    eb[ai][m][bj] = (seg < 2) ? *(const u32x2*)(p + DM) : (u32x2){0xffffffffu, 0xffffffffu}; }
        asm volatile("" ::: "memory");
#pragma unroll
        for (int ai = 0; ai < 2; ++ai)
#pragma unroll
            for (int m = 0; m < 4; ++m) {
                const int rr = ai * 128 + wr * 64 + m * 16 + fr;
#pragma unroll
                for (int bj = 0; bj < 2; ++bj) { const u32x2 a = ea[ai][m][bj], b = eb[ai][m][bj];
                    f32x4 f0, f1;
#pragma unroll
                    for (int i = 0; i < 4; ++i) { f0[i] = (float)((a.x >> (8 * i)) & 0xffu) * __builtin_amdgcn_rcpf((float)((b.x >> (8 * i)) & 0xffu)); f1[i] = (float)((a.y >> (8 * i)) & 0xffu) * __builtin_amdgcn_rcpf((float)((b.y >> (8 * i)) & 0xffu)); }
                    const f32x4 v0 = acc[ai][bj][m][0] * f0, v1 = acc[ai][bj][m][1] * f1;
                    if (seg < 2) { acc[ai][bj][m][0] = v0; acc[ai][bj][m][1] = v1; }
                    else { u32x4 w; w.x = cvt_pk_bf16(v0[0], v0[1]); w.y = cvt_pk_bf16(v0[2], v0[3]); w.z = cvt_pk_bf16(v1[0], v1[1]); w.w = cvt_pk_bf16(v1[2], v1[3]);
                        *(u32x4*)(O + ((size_t)u.pm * 256 + rr) * DM + u.pn * 256 + bj * 128 + wc * 32 + 8 * fq) = w;
                        acc[ai][bj][m][0] = (f32x4){0.f, 0.f, 0.f, 0.f}; acc[ai][bj][m][1] = (f32x4){0.f, 0.f, 0.f, 0.f}; } }
                if (seg == 2) asm volatile("" ::: "memory"); }
    }
};
struct EpiOut {
    static constexpr bool AFTER_DRAIN = false;
    const float* hsrc; const bf16* hsb; bf16* hb; const float* sa; const float* so;
    __device__ __forceinline__ void operator()(pg8::Acc& acc, const pg8::Unit& u, int wr, int wc, int fr, int fq) const {
        f32x4 cs[2][2];
#pragma unroll
        for (int bj = 0; bj < 2; ++bj) { if (I8_P6) { cs[bj][0] = *(const f32x4*)(so + u.pn * 256 + bj * 128 + wc * 32 + 8 * fq); cs[bj][1] = *(const f32x4*)(so + u.pn * 256 + bj * 128 + wc * 32 + 8 * fq + 4); }
            else { cs[bj][0] = (f32x4){1.f, 1.f, 1.f, 1.f}; cs[bj][1] = cs[bj][0]; } }
#pragma unroll
        for (int ai = 0; ai < 2; ++ai)
#pragma unroll
            for (int mp = 0; mp < 2; ++mp) {
                int rr = ai * 128 + wr * 64 + mp * 32 + fr; asm volatile("" : "+v"(rr));
                const size_t o0 = ((size_t)u.pm * 256 + rr) * DM + u.pn * 256 + wc * 32 + 8 * fq;
                f32x4 hv[2][2][2];
                float ra[2] = {1.f, 1.f};
                if (I8_P6) { ra[0] = sa[(size_t)u.pm * 256 + rr]; ra[1] = sa[(size_t)u.pm * 256 + rr + 16]; }
                if (hsrc) {
#pragma unroll
                    for (int mm = 0; mm < 2; ++mm)
#pragma unroll
                        for (int bj = 0; bj < 2; ++bj) { const size_t o = o0 + (size_t)mm * 16 * DM + bj * 128; hv[mm][bj][0] = *(const f32x4*)(hsrc + o); hv[mm][bj][1] = *(const f32x4*)(hsrc + o + 4); }
                } else { u32x4 hq[2][2];
#pragma unroll
                    for (int mm = 0; mm < 2; ++mm)
#pragma unroll
                        for (int bj = 0; bj < 2; ++bj) hq[mm][bj] = *(const u32x4*)(hsb + o0 + (size_t)mm * 16 * DM + bj * 128);
#pragma unroll
                    for (int mm = 0; mm < 2; ++mm)
#pragma unroll
                        for (int bj = 0; bj < 2; ++bj) { const u32x4 q = hq[mm][bj]; hv[mm][bj][0] = (f32x4){bf_lo(q.x), bf_hi(q.x), bf_lo(q.y), bf_hi(q.y)}; hv[mm][bj][1] = (f32x4){bf_lo(q.z), bf_hi(q.z), bf_lo(q.w), bf_hi(q.w)}; } }
#pragma unroll
                for (int mm = 0; mm < 2; ++mm)
#pragma unroll
                    for (int bj = 0; bj < 2; ++bj) { const int m = mp * 2 + mm; const size_t o = o0 + (size_t)mm * 16 * DM + bj * 128;
                        f32x4 d0 = acc[ai][bj][m][0], d1 = acc[ai][bj][m][1];
                        if (I8_P6) {
#pragma unroll
                            for (int i = 0; i < 4; ++i) { d0[i] = (float)__float_as_int(d0[i]) * ra[mm] * cs[bj][0][i]; d1[i] = (float)__float_as_int(d1[i]) * ra[mm] * cs[bj][1][i]; } }
                        const f32x4 v0 = hv[mm][bj][0] + d0, v1 = hv[mm][bj][1] + d1;
                        u32x4 w; w.x = cvt_pk_bf16(v0[0], v0[1]); w.y = cvt_pk_bf16(v0[2], v0[3]); w.z = cvt_pk_bf16(v1[0], v1[1]); w.w = cvt_pk_bf16(v1[2], v1[3]);
                        *(u32x4*)(hb + o) = w; }
                asm volatile("" ::: "memory"); }
        pg8::zero_acc(acc);
    }
};
struct EpiGate {
    static constexpr bool AFTER_DRAIN = false;
    const bf16* hin; float* dst; const bf16* er; const float* rse; const float* pg; bf16* hb; float* PS; LAS float* red; const float* sa; const float* sg;
    __device__ __forceinline__ void operator()(pg8::Acc& acc, const pg8::Unit& u, int wr, int wc, int fr, int fq) const {
        const int col0 = u.pn * 256 + wc * 32 + 8 * fq;
        f32x4 g[2][2];
#pragma unroll
        for (int bj = 0; bj < 2; ++bj) { g[bj][0] = *(const f32x4*)(pg + col0 + bj * 128); g[bj][1] = *(const f32x4*)(pg + col0 + bj * 128 + 4); }
        f32x4 cs[2][2];
#pragma unroll
        for (int bj = 0; bj < 2; ++bj) { if (I8_P7) { cs[bj][0] = *(const f32x4*)(sg + col0 + bj * 128) * -1.4426950408889634f; cs[bj][1] = *(const f32x4*)(sg + col0 + bj * 128 + 4) * -1.4426950408889634f; }
            else { cs[bj][0] = (f32x4){-1.4426950408889634f, -1.4426950408889634f, -1.4426950408889634f, -1.4426950408889634f}; cs[bj][1] = cs[bj][0]; } }
#pragma unroll
        for (int ai = 0; ai < 2; ++ai)
#pragma unroll
            for (int mp = 0; mp < 2; ++mp) {
                int rr = ai * 128 + wr * 64 + mp * 32 + fr; asm volatile("" : "+v"(rr));
                const size_t row0 = (size_t)u.pm * 256 + rr, o0 = row0 * DM + col0;
                u32x4 hq[2][2]; u32x4 ev[2][2]; float rs[2], ra[2];
#pragma unroll
                for (int mm = 0; mm < 2; ++mm) { const float* pp = rse + (row0 + mm * 16) * 8; const f32x4 q0 = *(const f32x4*)pp, q1 = *(const f32x4*)(pp + 4);
                    ra[mm] = I8_P7 ? sa[row0 + mm * 16] : 1.0f;
                    rs[mm] = 1.0f / sqrtf((((q0.x + q0.y) + (q0.z + q0.w)) + ((q1.x + q1.y) + (q1.z + q1.w))) * (1.f / DM) + EPS);
#pragma unroll
                    for (int bj = 0; bj < 2; ++bj) { const size_t o = o0 + (size_t)mm * 16 * DM + bj * 128; hq[mm][bj] = *(const u32x4*)(hin + o); ev[mm][bj] = *(const u32x4*)(er + o); } }
#pragma unroll
                for (int mm = 0; mm < 2; ++mm) { float ssq = 0.f;
#pragma unroll
                    for (int bj = 0; bj < 2; ++bj) { const int m = mp * 2 + mm; const size_t o = o0 + (size_t)mm * 16 * DM + bj * 128; const u32x4 e = ev[mm][bj], q = hq[mm][bj];
                        const f32x4 e0 = (f32x4){bf_lo(e.x), bf_hi(e.x), bf_lo(e.y), bf_hi(e.y)} * g[bj][0] * rs[mm], e1 = (f32x4){bf_lo(e.z), bf_hi(e.z), bf_lo(e.w), bf_hi(e.w)} * g[bj][1] * rs[mm];
                        f32x4 a0 = acc[ai][bj][m][0], a1 = acc[ai][bj][m][1];
#pragma unroll
                        for (int i = 0; i < 4; ++i) { if (I8_P7) { a0[i] = (float)__float_as_int(a0[i]) * ra[mm]; a1[i] = (float)__float_as_int(a1[i]) * ra[mm]; }
                            a0[i] = __builtin_amdgcn_rcpf(1.0f + __builtin_amdgcn_exp2f(cs[bj][0][i] * a0[i])); a1[i] = __builtin_amdgcn_rcpf(1.0f + __builtin_amdgcn_exp2f(cs[bj][1][i] * a1[i])); }
                        const f32x4 v0 = (f32x4){bf_lo(q.x), bf_hi(q.x), bf_lo(q.y), bf_hi(q.y)} + a0 * e0, v1 = (f32x4){bf_lo(q.z), bf_hi(q.z), bf_lo(q.w), bf_hi(q.w)} + a1 * e1;
                        if (dst) { *(f32x4*)(dst + o) = v0; *(f32x4*)(dst + o + 4) = v1; }
                        u32x4 w; w.x = cvt_pk_bf16(v0[0], v0[1]); w.y = cvt_pk_bf16(v0[2], v0[3]); w.z = cvt_pk_bf16(v1[0], v1[1]); w.w = cvt_pk_bf16(v1[2], v1[3]);
                        if (hb) *(u32x4*)(hb + o) = w;
                        ssq += ((v0.x * v0.x + v0.y * v0.y) + (v0.z * v0.z + v0.w * v0.w)) + ((v1.x * v1.x + v1.y * v1.y) + (v1.z * v1.z + v1.w * v1.w)); }
                    ssq += xlane<16>(ssq); ssq = xsum32(ssq);
                    if (fq == 0) red[(rr + mm * 16) * 4 + wc] = ssq; }
                asm volatile("" ::: "memory"); }
        LDS_WAIT(); __builtin_amdgcn_s_barrier(); asm volatile("" ::: "memory");
        { const int t2 = (wr * 4 + wc) * 64 + fq * 16 + fr;
          if (t2 < 256) { const f32x4 r4 = *(const LAS f32x4*)(red + t2 * 4); PS[((size_t)u.pm * 256 + t2) * 8 + u.pn] = (r4.x + r4.y) + (r4.z + r4.w); } }
        LDS_WAIT(); __builtin_amdgcn_s_barrier(); asm volatile("" ::: "memory");
        pg8::zero_acc(acc);
    }
};

constexpr int LRU_SEGC = 4, LRU_NSEG = 64 / LRU_SEGC, LRU_UNITS = NBATCH * LRU_NSEG * 8;
template <int PASS>
__device__ __forceinline__ void lru_unit(const Frame& F, int tid, int lane, int l, int unit, const bf16* gw, bool dummy = false) {
    typedef float f32x16 __attribute__((ext_vector_type(16)));
    const int cg = unit & 7, seg = (unit >> 3) & (LRU_NSEG - 1), b = unit / (8 * LRU_NSEG), ch0 = cg * 128;
    LAS float* ucf = (LAS float*)F.lds;
    LAS bf16* ucb = (LAS bf16*)(F.lds + 32768);
    LAS float* tot = (LAS float*)(F.lds + 32768 + 17408);
    float* SUMA = (float*)(F.ws + WS_LRUS); float* SUMD = SUMA + NBATCH * LRU_NSEG * BW;
    constexpr int UP = 136;
    const int wid = F.wave, tt = wid & 1, jt = wid >> 1, blk = jt >> 1, j0 = (jt & 1) * 32, r32 = lane & 31, hi = lane >> 5;
    const int co = tid & 15, tk0 = tid >> 4, chc = ch0 + co * 8;
    const int chl = jt * 32 + r32, ch = ch0 + chl;
    float cw[4][8], cb[8];
#pragma unroll
    for (int q = 0; q < 4; ++q) { const f32x4 a = *(const f32x4*)(INP(I_CONVW) + ((size_t)l * 4 + q) * BW + chc), c = *(const f32x4*)(INP(I_CONVW) + ((size_t)l * 4 + q) * BW + chc + 4);
        cw[q][0] = a.x; cw[q][1] = a.y; cw[q][2] = a.z; cw[q][3] = a.w; cw[q][4] = c.x; cw[q][5] = c.y; cw[q][6] = c.z; cw[q][7] = c.w; }
    { const f32x4 a = *(const f32x4*)(INP(I_CONVB) + (size_t)l * BW + chc), c = *(const f32x4*)(INP(I_CONVB) + (size_t)l * BW + chc + 4);
      cb[0] = a.x; cb[1] = a.y; cb[2] = a.z; cb[3] = a.w; cb[4] = c.x; cb[5] = c.y; cb[6] = c.z; cb[7] = c.w; }
    bf16x8 fwa[4], fwx[4];
    { const bf16* wa = gw + ((size_t)(cg * 2 + blk) * 64 + j0 + r32) * 64 + hi * 8;
#pragma unroll
      for (int ks = 0; ks < 4; ++ks) { fwa[ks] = *(const bf16x8*)(wa + ks * 16); fwx[ks] = *(const bf16x8*)(wa + 16 * 4096 + ks * 16); } }
    const float ba = INP(I_BA)[(size_t)l * BW + ch], bx = INP(I_BX)[(size_t)l * BW + ch], lam = INP(I_LAM)[(size_t)l * BW + ch];
    const float sp8 = -8.0f * 1.4426950408889634f * ((-lam > 20.f) ? -lam : log1pf(__expf(-lam)));
    const bf16* U = ZP(Z_U) + chc;
    u32x4 up[2][4];
    u32x4 gpre[2] = {{0u, 0u, 0u, 0u}, {0u, 0u, 0u, 0u}};
#define LRU_LOADU(tch_) do { _Pragma("unroll") for (int i_ = 0; i_ < 2; ++i_) { const int sq_ = (tch_) * 64 + tk0 + 32 * i_; _Pragma("unroll") for (int q_ = 0; q_ < 4; ++q_) \
        up[i_][q_] = (sq_ - 3 + q_ >= 0) ? *(const u32x4*)(U + ((size_t)b * SEQ + sq_ - 3 + q_) * BW) : (u32x4){0u, 0u, 0u, 0u}; } } while (0)
#define LRU_LOADG(tch_, dst) do { if (PASS == 2) { _Pragma("unroll") for (int i_ = 0; i_ < 2; ++i_) dst[i_] = *(const u32x4*)(ZP(Z_GA) + ((size_t)b * SEQ + (tch_) * 64 + tk0 + 32 * i_) * BW + chc); } } while (0)
    LRU_LOADU(seg * LRU_SEGC); LRU_LOADG(seg * LRU_SEGC, gpre);
    float sA = 1.f, sD = 0.f, h = 0.f;
    if (PASS == 2) { const float* sa = SUMA + (size_t)b * LRU_NSEG * BW + ch; const float* sd = SUMD + (size_t)b * LRU_NSEG * BW + ch;
        float fa[LRU_NSEG - 1], fd[LRU_NSEG - 1];
#pragma unroll
        for (int c = 0; c < LRU_NSEG - 1; ++c) { const bool on = c < seg; fa[c] = on ? sa[(size_t)c * BW] : 1.f; fd[c] = on ? sd[(size_t)c * BW] : 0.f; }
#pragma unroll
        for (int c = 0; c < LRU_NSEG - 1; ++c) h = fa[c] * h + fd[c]; }
    for (int ci = 0; ci < LRU_SEGC; ++ci) {
        const int tch = seg * LRU_SEGC + ci, t0 = tch * 64;
        __syncthreads();
#pragma unroll
        for (int i = 0; i < 2; ++i) { const int tk = tk0 + 32 * i;
            float uc[8];
#pragma unroll
            for (int e = 0; e < 8; ++e) uc[e] = cb[e];
#pragma unroll
            for (int q = 0; q < 4; ++q) { const u32x4 w = up[i][q];
                uc[0] += cw[q][0] * bf_lo(w.x); uc[1] += cw[q][1] * bf_hi(w.x); uc[2] += cw[q][2] * bf_lo(w.y); uc[3] += cw[q][3] * bf_hi(w.y);
                uc[4] += cw[q][4] * bf_lo(w.z); uc[5] += cw[q][5] * bf_hi(w.z); uc[6] += cw[q][6] * bf_lo(w.w); uc[7] += cw[q][7] * bf_hi(w.w); }
            *(LAS f32x4*)(ucf + tk * 128 + co * 8) = (f32x4){uc[0], uc[1], uc[2], uc[3]}; *(LAS f32x4*)(ucf + tk * 128 + co * 8 + 4) = (f32x4){uc[4], uc[5], uc[6], uc[7]};
            u32x4 p; p.x = cvt_pk_bf16(uc[0], uc[1]); p.y = cvt_pk_bf16(uc[2], uc[3]); p.z = cvt_pk_bf16(uc[4], uc[5]); p.w = cvt_pk_bf16(uc[6], uc[7]);
            *(LAS u32x4*)(ucb + tk * UP + co * 8) = p; }
        u32x4 gcur[2] = {gpre[0], gpre[1]};
        if (ci + 1 < LRU_SEGC) { LRU_LOADU(tch + 1); LRU_LOADG(tch + 1, gpre); }
        __syncthreads();
        f32x16 ar = {}, ax = {};
#pragma unroll
        for (int ks = 0; ks < 4; ++ks) {
            const bf16x8 af = *(const LAS bf16x8*)(ucb + (tt * 32 + r32) * UP + blk * 64 + ks * 16 + hi * 8);
            ar = __builtin_amdgcn_mfma_f32_32x32x16_bf16(af, fwa[ks], ar, 0, 0, 0);
            ax = __builtin_amdgcn_mfma_f32_32x32x16_bf16(af, fwx[ks], ax, 0, 0, 0);
        }
#pragma unroll
        for (int r = 0; r < 16; ++r) { const int tk = tt * 32 + (r & 3) + 8 * (r >> 2) + 4 * hi;
            constexpr float L2E = 1.4426950408889634f;
            const float rec = __builtin_amdgcn_rcpf(1.0f + __builtin_amdgcn_exp2f(-L2E * (ar[r] + ba))), inp = __builtin_amdgcn_rcpf(1.0f + __builtin_amdgcn_exp2f(-L2E * (ax[r] + bx)));
            const float a = __builtin_amdgcn_exp2f(rec * sp8);
            ar[r] = a; ax[r] = __builtin_amdgcn_sqrtf(fmaf(-a, a, 1.0f)) * (inp * ucf[tk * 128 + chl]); }
        float gA[4], gD[4];
#pragma unroll
        for (int g = 0; g < 4; ++g) { gA[g] = ar[4 * g]; gD[g] = ax[4 * g];
#pragma unroll
            for (int i = 1; i < 4; ++i) { gD[g] = gD[g] * ar[4 * g + i] + ax[4 * g + i]; gA[g] *= ar[4 * g + i]; } }
        float pA[4], pD[4], TA = 1.f, TD = 0.f;
#pragma unroll
        for (int g = 0; g < 4; ++g) {
            const auto ra = __builtin_amdgcn_permlane32_swap(__float_as_uint(gA[g]), __float_as_uint(gA[g]), false, false);
            const auto rd = __builtin_amdgcn_permlane32_swap(__float_as_uint(gD[g]), __float_as_uint(gD[g]), false, false);
            const float a0 = __uint_as_float(ra[0]), a1 = __uint_as_float(ra[1]), d0 = __uint_as_float(rd[0]), d1 = __uint_as_float(rd[1]);
            const float midA = TA * a0, midD = TD * a0 + d0;
            pA[g] = hi ? midA : TA; pD[g] = hi ? midD : TD;
            TA = midA * a1; TD = midD * a1 + d1; }
        if (hi == 0) { tot[(wid * 2 + 0) * 32 + r32] = TA; tot[(wid * 2 + 1) * 32 + r32] = TD; }
        __syncthreads();
        const float A0 = tot[((wid & ~1) * 2 + 0) * 32 + r32], D0 = tot[((wid & ~1) * 2 + 1) * 32 + r32];
        const float A1 = tot[((wid | 1) * 2 + 0) * 32 + r32], D1 = tot[((wid | 1) * 2 + 1) * 32 + r32];
        const float CA = A0 * A1, CD = D0 * A1 + D1;
        if (PASS == 1) { sD = sD * CA + CD; sA *= CA; }
        else {
            const float hin = tt ? A0 * h + D0 : h;
#pragma unroll
            for (int g = 0; g < 4; ++g) { float hg = pA[g] * hin + pD[g];
#pragma unroll
                for (int i = 0; i < 4; ++i) { hg = ar[4 * g + i] * hg + ax[4 * g + i]; ucf[(tt * 32 + 8 * g + 4 * hi + i) * 128 + chl] = hg; } }
            h = CA * h + CD;
            __syncthreads();
#pragma unroll
            for (int i = 0; i < 2; ++i) { const int tk = tk0 + 32 * i; const size_t o = ((size_t)b * SEQ + t0 + tk) * BW + chc;
                const f32x4 h0 = *(const LAS f32x4*)(ucf + tk * 128 + co * 8), h1 = *(const LAS f32x4*)(ucf + tk * 128 + co * 8 + 4);
                const u32x4 gt = gcur[i]; u32x4 y;
                y.x = cvt_pk_bf16(h0.x * bf_lo(gt.x), h0.y * bf_hi(gt.x)); y.y = cvt_pk_bf16(h0.z * bf_lo(gt.y), h0.w * bf_hi(gt.y));
                y.z = cvt_pk_bf16(h1.x * bf_lo(gt.z), h1.y * bf_hi(gt.z)); y.w = cvt_pk_bf16(h1.z * bf_lo(gt.w), h1.w * bf_hi(gt.w));
                *(u32x4*)((dummy ? (bf16*)(F.ws + WS_X1) : ZP(Z_GA)) + o) = y; }
        }
    }
#undef LRU_LOADU
#undef LRU_LOADG
    if (PASS == 1) { if (tt == 0 && hi == 0) { const size_t o = ((size_t)b * LRU_NSEG + seg) * BW + ch; SUMA[o] = sA; SUMD[o] = sD; } }
}
__device__ __forceinline__ void fox_cumsum_item(const Frame& F, int lane, int item) {
    const int b = item >> 3, h = item & 7; const float* LF = (const float*)(F.ws + WS_Z + Z_LF); float* CF = (float*)(F.ws + WS_Z + Z_CF);
    const size_t r0 = (size_t)b * SEQ + lane * 64;
    float s = 0.f;
    for (int t = 0; t < 64; ++t) s += LF[(r0 + t) * 8 + h];
    float inc = s;
#pragma unroll
    for (int o = 1; o < 64; o <<= 1) { const float v = __int_as_float(__builtin_amdgcn_ds_bpermute((lane - o) << 2, __float_as_int(inc))); if (lane >= o) inc += v; }
    float run = inc - s;
    for (int t = 0; t < 64; ++t) { run += LF[(r0 + t) * 8 + h]; CF[((size_t)b * 8 + h) * SEQ + lane * 64 + t] = run * (-1.0f / SCALE); }
}
__device__ __forceinline__ void phase_erstd(const Frame& F0) {
    const Frame F = pin(F0); PHASE_IDS();
    const bf16* er = (const bf16*)(F.ws + WS_X1); float* rse = (float*)(F.ws + WS_RSE);
    const int gw = F.vcu * NWAVES + F.wave, NGW = F.G * NWAVES;
    for (int m = gw; m < T; m += NGW) { const u32x4* r = (const u32x4*)(er + (size_t)m * DM) + lane; float s = 0.f;
#pragma unroll
        for (int q = 0; q < 4; ++q) { const u32x4 w = r[64 * q]; float a;
            a = bf_lo(w.x); s += a * a; a = bf_hi(w.x); s += a * a; a = bf_lo(w.y); s += a * a; a = bf_hi(w.y); s += a * a;
            a = bf_lo(w.z); s += a * a; a = bf_hi(w.z); s += a * a; a = bf_lo(w.w); s += a * a; a = bf_hi(w.w); s += a * a; }
        s = wave_sum(s); if (lane == 0) rse[m] = 1.0f / sqrtf(s * (1.f / DM) + EPS); }
}

namespace att {
typedef short s16x4 __attribute__((ext_vector_type(4)));
typedef float f32x16 __attribute__((ext_vector_type(16)));
constexpr int KVBLK = 64, SHM_V = 16384, SHM_K = 16384;
constexpr float THR = 8.f;
#define KSWZ(row, colB) ((row) * 256 + ((colB) ^ (((row) & 7) << 4)))
#define SBAR() __builtin_amdgcn_sched_barrier(0)
__device__ __forceinline__ int v_st(int k, int c) { const int kk = (k & ~0xC) | ((k & 4) << 1) | ((k & 8) >> 1); return ((kk >> 3) * 4 + (c >> 5)) * 512 + ((kk & 7) * 32 + (c & 31)) * 2; }
__device__ __forceinline__ int v_rd_base(int lane) { return ((lane & 3) << 3) | (((lane >> 2) & 3) << 6) | (((lane >> 4) & 1) << 5) | (((lane >> 5) & 1) << 8); }
constexpr int v_rd_off(int d0, int ks, int half) { return d0 * 512 + ks * 4096 + half * 2048; }
__device__ __forceinline__ int crow(int r, int hi) { return (r & 3) + 8 * (r >> 2) + 4 * hi; }
__device__ __forceinline__ void mask_tile(f32x16& p0, f32x16& p1, int dq, unsigned W) {
    const float NEG = -__builtin_inff();
#pragma unroll
    for (int r = 0; r < 16; ++r) {
        const int c = (r & 3) + 8 * (r >> 2);
        if ((unsigned)(dq - c) >= W) p0[r] = NEG;
        if ((unsigned)(dq - c - 32) >= W) p1[r] = NEG;
    }
}
template <bool GATED = false>
__device__ __forceinline__ void partialSM(f32x16& p0, f32x16& p1, float& m_reg, float& mn, float& alpha, bool lane_on = true) {
    float pmax = p0[0];
#pragma unroll
    for (int r = 1; r < 16; ++r) pmax = fmaxf(pmax, p0[r]);
#pragma unroll
    for (int r = 0; r < 16; ++r) pmax = fmaxf(pmax, p1[r]);
    { auto rr = __builtin_amdgcn_permlane32_swap(__float_as_uint(pmax), __float_as_uint(pmax), false, false);
      pmax = fmaxf(__uint_as_float(rr[0]), __uint_as_float(rr[1])); }
    constexpr float C2 = 1.4426950408889634f * SCALE;
    if (GATED) { if (!lane_on) pmax = -__builtin_inff(); }
    if (__builtin_expect(__all((pmax - m_reg) * SCALE <= THR), 1)) { mn = m_reg; alpha = 1.f; }
    else { mn = fmaxf(m_reg, pmax); alpha = __builtin_amdgcn_exp2f((m_reg - mn) * C2); m_reg = mn; }
    float mnL = -mn * C2;
    if (GATED) { if (!lane_on) mnL = -__builtin_inff(); }
#pragma unroll
    for (int r = 0; r < 16; ++r) p0[r] = fmaf(p0[r], C2, mnL);
#pragma unroll
    for (int r = 0; r < 16; ++r) p1[r] = fmaf(p1[r], C2, mnL);
#pragma unroll
    for (int r = 0; r < 16; ++r) p0[r] = __builtin_amdgcn_exp2f(p0[r]);
}
#define PK4(P, B_, OUT) do { unsigned a0 = cvt_pk_bf16(P[B_+0], P[B_+1]), a1 = cvt_pk_bf16(P[B_+2], P[B_+3]);                          \
        unsigned b0 = cvt_pk_bf16(P[B_+4], P[B_+5]), b1 = cvt_pk_bf16(P[B_+6], P[B_+7]);                                             \
        auto r0 = __builtin_amdgcn_permlane32_swap(a0, b0, false, false); auto r1 = __builtin_amdgcn_permlane32_swap(a1, b1, false, false); \
        u32x4 w = {r0[0], r1[0], r0[1], r1[1]}; OUT = *reinterpret_cast<bf16x8*>(&w); } while (0)
__device__ __forceinline__ void finishSM(f32x16& p0, f32x16& p1, float alpha, float& l_reg, bf16x8& pa0, bf16x8& pa1, bf16x8& pa2, bf16x8& pa3) {
#pragma unroll
    for (int r = 0; r < 16; ++r) p1[r] = __builtin_amdgcn_exp2f(p1[r]);
    float ps = 0;
#pragma unroll
    for (int r = 0; r < 16; ++r) ps += p0[r];
#pragma unroll
    for (int r = 0; r < 16; ++r) ps += p1[r];
    ps = xsum32(ps);
    l_reg = l_reg * alpha + ps;
    PK4(p0, 0, pa0); PK4(p0, 8, pa1); PK4(p1, 0, pa2); PK4(p1, 8, pa3);
}
__device__ __forceinline__ void qkt(f32x16& p0, f32x16& p1, const LAS char* kt, int r32, int hi, const bf16x8* qr) {
    p0 = f32x16{}; p1 = f32x16{};
    const LAS char* kb[4];
#pragma unroll
    for (int dd = 0; dd < 4; ++dd) kb[dd] = kt + KSWZ(r32, (dd * 16 + hi * 8) * 2);
#pragma unroll
    for (int d0 = 0; d0 < 8; ++d0) { const LAS char* a = kb[d0 & 3] + (d0 >> 2) * 128;
        bf16x8 b0 = *reinterpret_cast<const LAS bf16x8*>(a);
        bf16x8 b1 = *reinterpret_cast<const LAS bf16x8*>(a + 32 * 256);
        p0 = __builtin_amdgcn_mfma_f32_32x32x16_bf16(b0, qr[d0], p0, 0, 0, 0);
        p1 = __builtin_amdgcn_mfma_f32_32x32x16_bf16(b1, qr[d0], p1, 0, 0, 0); }
}
template <int VOFF>
__device__ __forceinline__ void pv_tile(f32x16* o, int vb0, bf16x8 pa0, bf16x8 pa1, bf16x8 pa2, bf16x8 pa3) {
#define TRRD(dst, off) asm volatile("ds_read_b64_tr_b16 %0, %1 offset:%2" : "=&v"(dst) : "v"(vb0), "i"(off) : "memory")
#define PV_D0(d0) do { s16x4 l0, l1, l2, l3, h0, h1, h2, h3; constexpr int b_ = VOFF + v_rd_off(d0, 0, 0); \
        TRRD(l0, b_); TRRD(h0, b_ + 2048); TRRD(l1, b_ + 4096); TRRD(h1, b_ + 6144); TRRD(l2, b_ + 8192); TRRD(h2, b_ + 10240); TRRD(l3, b_ + 12288); TRRD(h3, b_ + 14336); \
        asm volatile("s_waitcnt lgkmcnt(0)" ::: "memory"); SBAR();   \
        o[d0] = __builtin_amdgcn_mfma_f32_32x32x16_bf16(pa0, (bf16x8){l0[0], l0[1], l0[2], l0[3], h0[0], h0[1], h0[2], h0[3]}, o[d0], 0, 0, 0);   \
        o[d0] = __builtin_amdgcn_mfma_f32_32x32x16_bf16(pa1, (bf16x8){l1[0], l1[1], l1[2], l1[3], h1[0], h1[1], h1[2], h1[3]}, o[d0], 0, 0, 0);   \
        o[d0] = __builtin_amdgcn_mfma_f32_32x32x16_bf16(pa2, (bf16x8){l2[0], l2[1], l2[2], l2[3], h2[0], h2[1], h2[2], h2[3]}, o[d0], 0, 0, 0);   \
        o[d0] = __builtin_amdgcn_mfma_f32_32x32x16_bf16(pa3, (bf16x8){l3[0], l3[1], l3[2], l3[3], h3[0], h3[1], h3[2], h3[3]}, o[d0], 0, 0, 0); } while (0)
    PV_D0(0); PV_D0(1); PV_D0(2); PV_D0(3);
#undef PV_D0
#undef TRRD
}

typedef float f32x2 __attribute__((ext_vector_type(2)));
#define MF32(a_, b_, c_) __builtin_amdgcn_mfma_f32_32x32x16_bf16(a_, b_, c_, 0, 0, 0)
#define MAX8(P0_, P1_, j) fmaxf(fmaxf(fmaxf(fmaxf(fmaxf(fmaxf(fmaxf(P0_[4 * (j)], P0_[4 * (j) + 1]), P0_[4 * (j) + 2]), P0_[4 * (j) + 3]), P1_[4 * (j)]), P1_[4 * (j) + 1]), P1_[4 * (j) + 2]), P1_[4 * (j) + 3])
#define PIN(x) asm volatile("" : "+v"(x))
template <bool FOXB>
__device__ __forceinline__ void qkt_fin(f32x16& x0, f32x16& x1, const LAS char* kt, int r32, int hi, const bf16x8* qr, const LAS float* cbp,
                                        f32x16& y0, f32x16& y1, float alpha, float& l_reg, bf16x8& pa0, bf16x8& pa1, bf16x8& pa2, bf16x8& pa3) {
    const LAS char* kb[4];
#pragma unroll
    for (int dd = 0; dd < 4; ++dd) kb[dd] = kt + KSWZ(r32, (dd * 16 + hi * 8) * 2);
#define KRD(k) (*reinterpret_cast<const LAS bf16x8*>(kb[((k) >> 1) & 3] + ((k) >> 3) * 128 + ((k) & 1) * (32 * 256)))
    bf16x8 kf[16];
    kf[0] = KRD(0); kf[1] = KRD(1); kf[2] = KRD(2); kf[3] = KRD(3);
    if (FOXB) {
#pragma unroll
        for (int g_ = 0; g_ < 4; ++g_) { const f32x4 c0 = *(const LAS f32x4*)(cbp + 8 * g_), c1 = *(const LAS f32x4*)(cbp + 32 + 8 * g_);
#pragma unroll
            for (int i_ = 0; i_ < 4; ++i_) { x0[4 * g_ + i_] = c0[i_]; x1[4 * g_ + i_] = c1[i_]; } }
    } else { x0 = f32x16{}; x1 = f32x16{}; }
    SBAR();
    f32x2 a0, a1, a2, a3, b0, b1; float s0 = 0.f, s1 = 0.f;
#define QS(k, VALU_) do { if ((k) + 4 < 16) kf[((k) + 4) & 15] = KRD(((k) + 4) & 15); \
        if ((k) & 1) x1 = MF32(kf[k], qr[(k) >> 1], x1); else x0 = MF32(kf[k], qr[(k) >> 1], x0); VALU_; SBAR(); } while (0)
#define EX2(j) do { y1[2 * (j)] = __builtin_amdgcn_exp2f(y1[2 * (j)]); y1[2 * (j) + 1] = __builtin_amdgcn_exp2f(y1[2 * (j) + 1]); } while (0)
#define PKS(Y_, j) ((f32x2){Y_[4 * (j)], Y_[4 * (j) + 1]} + (f32x2){Y_[4 * (j) + 2], Y_[4 * (j) + 3]})
    QS(0, EX2(0); a0 = PKS(y0, 0); PIN(y1); PIN(a0));
    QS(1, EX2(1); a1 = PKS(y0, 1); PIN(y1); PIN(a1));
    QS(2, EX2(2); a2 = PKS(y0, 2); PIN(y1); PIN(a2));
    QS(3, EX2(3); a3 = PKS(y0, 3); PIN(y1); PIN(a3));
    QS(4, EX2(4); b0 = a0 + a1; PIN(y1); PIN(b0));
    QS(5, EX2(5); b1 = a2 + a3; PIN(y1); PIN(b1));
    QS(6, EX2(6); b0 = b0 + b1; PIN(y1); PIN(b0));
    QS(7, EX2(7); s0 = b0.x + b0.y; PIN(y1); PIN(s0));
    QS(8, a0 = PKS(y1, 0); a1 = PKS(y1, 1); PK4(y0, 0, pa0); PIN(a0); PIN(a1); PIN(pa0));
    QS(9, a2 = PKS(y1, 2); a3 = PKS(y1, 3); PK4(y0, 8, pa1); PIN(a2); PIN(a3); PIN(pa1));
    QS(10, b0 = a0 + a1; b1 = a2 + a3; b0 = b0 + b1; s1 = b0.x + b0.y; PIN(s1));
    QS(11, { float ps = xsum32(s0 + s1); l_reg = l_reg * alpha + ps; PIN(l_reg); });
    QS(12, PK4(y1, 0, pa2); PIN(pa2));
    QS(13, PK4(y1, 8, pa3); PIN(pa3));
    QS(14, );
    QS(15, );
#undef QS
#undef EX2
#undef PKS
#undef KRD
}
template <int VOFF, bool GATED>
__device__ __forceinline__ void pv_psm(f32x16 (&o)[4], const LAS char* vb, bf16x8 pa0, bf16x8 pa1, bf16x8 pa2, bf16x8 pa3,
                                       f32x16& p0, f32x16& p1, float& m_reg, float& mn, float& alpha, bool lane_on) {
    constexpr float C2 = 1.4426950408889634f * SCALE;
#define VFR(k) ({ const s16x4 l_ = __builtin_amdgcn_ds_read_tr16_b64_v4i16((LAS s16x4*)(vb + VOFF + v_rd_off((k) & 3, 0, 0) + 4096 * ((k) >> 2))); \
                  const s16x4 h_ = __builtin_amdgcn_ds_read_tr16_b64_v4i16((LAS s16x4*)(vb + VOFF + v_rd_off((k) & 3, 0, 0) + 4096 * ((k) >> 2) + 2048)); \
                  (bf16x8){l_[0], l_[1], l_[2], l_[3], h_[0], h_[1], h_[2], h_[3]}; })
    bf16x8 vf[16];
    vf[0] = VFR(0); vf[1] = VFR(1); vf[2] = VFR(2);
    SBAR();
    float q0, q1, q2, q3, mnL = 0.f;
#define PS(k, VALU_) do { if ((k) + 3 < 16) vf[((k) + 3) & 15] = VFR(((k) + 3) & 15); \
        o[(k) & 3] = MF32((k) < 4 ? pa0 : (k) < 8 ? pa1 : (k) < 12 ? pa2 : pa3, vf[k], o[(k) & 3]); VALU_; SBAR(); } while (0)
#define FM8(P_, j) do { _Pragma("unroll") for (int r_ = 8 * (j); r_ < 8 * (j) + 8; ++r_) P_[r_] = fmaf(P_[r_], C2, mnL); } while (0)
#define EP2(j) do { p0[2 * (j)] = __builtin_amdgcn_exp2f(p0[2 * (j)]); p0[2 * (j) + 1] = __builtin_amdgcn_exp2f(p0[2 * (j) + 1]); } while (0)
    PS(0, q0 = MAX8(p0, p1, 0); PIN(q0));
    PS(1, q1 = MAX8(p0, p1, 1); PIN(q1));
    PS(2, q2 = MAX8(p0, p1, 2); PIN(q2));
    PS(3, q3 = MAX8(p0, p1, 3); PIN(q3));
    PS(4, { float pmax = fmaxf(fmaxf(q0, q1), fmaxf(q2, q3));
            { auto rr = __builtin_amdgcn_permlane32_swap(__float_as_uint(pmax), __float_as_uint(pmax), false, false); pmax = fmaxf(__uint_as_float(rr[0]), __uint_as_float(rr[1])); }
            if (GATED) pmax = lane_on ? pmax : -__builtin_inff();
            const bool keep = __all((pmax - m_reg) * SCALE <= THR);
            mn = keep ? m_reg : fmaxf(m_reg, pmax); alpha = __builtin_amdgcn_exp2f((m_reg - mn) * C2); m_reg = mn;
            mnL = -mn * C2; if (GATED) mnL = lane_on ? mnL : -__builtin_inff(); PIN(mnL); PIN(alpha); PIN(m_reg); });
    PS(5, FM8(p0, 0); PIN(p0));
    PS(6, FM8(p0, 1); PIN(p0));
    PS(7, FM8(p1, 0); EP2(0); PIN(p0); PIN(p1));
    PS(8, FM8(p1, 1); EP2(1); PIN(p0); PIN(p1));
    PS(9, EP2(2); PIN(p0));
    PS(10, EP2(3); PIN(p0));
    PS(11, EP2(4); PIN(p0));
    PS(12, EP2(5); PIN(p0));
    PS(13, EP2(6); PIN(p0));
    PS(14, EP2(7); PIN(p0));
    PS(15, );
#undef PS
#undef FM8
#undef EP2
#undef VFR
}
enum { M_FOX = 0, M_SEL = 1, M_WIN = 2 };
constexpr int STREAM_LDS = 2 * SHM_V + 2 * SHM_K + 512 + 8 * 256;
#define ATT_PRELOAD(Kh_, Vh_, k0_, tid_, pk0_, pk1_, pv0_, pv1_) do { const int sr_ = (tid_) >> 4, sc_ = ((tid_) & 15) * 8; \
        pv0_ = *(const bf16x8*)((Vh_) + (size_t)((k0_) + sr_) * HD + sc_); pv1_ = *(const bf16x8*)((Vh_) + (size_t)((k0_) + 32 + sr_) * HD + sc_); \
        pk0_ = *(const bf16x8*)((Kh_) + (size_t)((k0_) + sr_) * HD + sc_); pk1_ = *(const bf16x8*)((Kh_) + (size_t)((k0_) + 32 + sr_) * HD + sc_); } while (0)
template <int MODE, bool CONT = false, bool PRE = false, bool DESC = false>
__device__ __forceinline__ void attn_stream(LAS char* lds, int tid, int wid, int lane, const bf16x8 (&qr)[8], const bf16* Kh, const bf16* Vh, const float* cb,
                                            int j_lo, int NT, int qpos, int qlo, int qhi, unsigned selLo, unsigned selHi, f32x16 (&o)[4], float& m_reg, float& l_reg,
                                            bf16x8 pk0 = bf16x8{}, bf16x8 pk1 = bf16x8{}, bf16x8 pv0 = bf16x8{}, bf16x8 pv1 = bf16x8{}) {
    const int r32 = lane & 31, hi = lane >> 5;
    LAS char* V_lds = lds; LAS char* K_lds = lds + 2 * SHM_V; LAS float* CB_lds = (LAS float*)(lds + 2 * SHM_V + 2 * SHM_K);
    LAS float* al_l = (LAS float*)(lds + 2 * SHM_V + 2 * SHM_K + 512) + wid * 64;
    const int sr = tid >> 4, sc = (tid & 15) * 8, vst0 = v_st(sr, sc), vst1 = v_st(32 + sr, sc), kws = KSWZ(sr, sc * 2);
    const int vb0 = (int)(unsigned)(uintptr_t)V_lds + v_rd_base(lane);
    const int qm = qpos - 4 * hi;
    f32x16 pA0, pA1, pB0, pB1; float mnA, mnB, alA, alB; bf16x8 pa0, pa1, pa2, pa3;
    bf16x8 st_v0, st_v1, st_k0, st_k1;
#define TILE(t) (DESC ? (j_lo + NT - 1 - (t)) : (j_lo + (t)))
#define KBASE(t) (TILE(t) * KVBLK)
#define VMW() asm volatile("s_waitcnt vmcnt(0)" ::: "memory")
#define SLOAD(k0, bf) do { st_v0 = *(const bf16x8*)(Vh + (size_t)((k0) + sr) * HD + sc); st_v1 = *(const bf16x8*)(Vh + (size_t)((k0) + 32 + sr) * HD + sc); \
        st_k0 = *(const bf16x8*)(Kh + (size_t)((k0) + sr) * HD + sc); st_k1 = *(const bf16x8*)(Kh + (size_t)((k0) + 32 + sr) * HD + sc); \
        if (MODE == M_FOX) { if (wid == 0) __builtin_amdgcn_global_load_lds((const unsigned*)(cb + (k0) + lane), (LAS unsigned*)(CB_lds + (bf) * 64), 4, 0, 0); } } while (0)
#define SWRITE(bf) do { *(LAS bf16x8*)(K_lds + (bf) * SHM_K + kws) = st_k0; *(LAS bf16x8*)(K_lds + (bf) * SHM_K + kws + 32 * 256) = st_k1; \
        *(LAS bf16x8*)(V_lds + (bf) * SHM_V + vst0) = st_v0; *(LAS bf16x8*)(V_lds + (bf) * SHM_V + vst1) = st_v1; } while (0)
#define RESC(a) do { if (__any((a) < 1.f)) { if (hi == 0) al_l[r32] = (a); asm volatile("s_waitcnt lgkmcnt(0)" ::: "memory");              \
                     for (int d_ = 0; d_ < 4; ++d_) for (int r = 0; r < 16; ++r) o[d_][r] *= al_l[crow(r, hi)]; } } while (0)
#define BIAS(P0_, P1_, bf) do { if (MODE == M_FOX) { const LAS float* cbp = CB_lds + (bf) * 64 + 4 * hi; \
        _Pragma("unroll") for (int g_ = 0; g_ < 4; ++g_) { const f32x4 c0 = *(const LAS f32x4*)(cbp + 8 * g_), c1 = *(const LAS f32x4*)(cbp + 32 + 8 * g_); \
            _Pragma("unroll") for (int i_ = 0; i_ < 4; ++i_) { P0_[4 * g_ + i_] += c0[i_]; P1_[4 * g_ + i_] += c1[i_]; } } } } while (0)
#define MASKT(P0_, P1_, t) do { const int kb_ = KBASE(t); \
        if (MODE == M_FOX) { if (kb_ + KVBLK - 1 > qlo) mask_tile(P0_, P1_, qm - kb_, 0x80000000u); } \
        else if (MODE == M_WIN) { if (kb_ + KVBLK - 1 > qlo || kb_ <= qhi - 512) mask_tile(P0_, P1_, qm - kb_, 512u); } \
        else { if (kb_ + KVBLK - 1 > qlo) mask_tile(P0_, P1_, qm - kb_, 0x80000000u); } } while (0)
#define LANEON(t) ((MODE != M_SEL) || (((TILE(t) < 32 ? (selLo >> TILE(t)) : (selHi >> (TILE(t) - 32))) & 1u) != 0u))
    __syncthreads();
    if (PRE) { st_k0 = pk0; st_k1 = pk1; st_v0 = pv0; st_v1 = pv1;
        if (MODE == M_FOX) { if (wid == 0) __builtin_amdgcn_global_load_lds((const unsigned*)(cb + KBASE(0) + lane), (LAS unsigned*)CB_lds, 4, 0, 0); } }
    else SLOAD(KBASE(0), 0);
    VMW(); SWRITE(0);
    if (NT > 1) SLOAD(KBASE(1), 1);
    __syncthreads();
    SBAR(); qkt(pA0, pA1, K_lds, r32, hi, qr);
    BIAS(pA0, pA1, 0); MASKT(pA0, pA1, 0); partialSM<MODE == M_SEL>(pA0, pA1, m_reg, mnA, alA, LANEON(0));
    if (NT > 1) { VMW(); SWRITE(1); }
    if (CONT) RESC(alA);
    __syncthreads();
#define HALF_STEP(PX0, PX1, mnX, alX, PY0, PY1, alY, t, KB, VB, SB) do {                                                      \
        SBAR(); qkt_fin<MODE == M_FOX>(PX0, PX1, K_lds + (KB) * SHM_K, r32, hi, qr, CB_lds + (KB) * 64 + 4 * hi, PY0, PY1, alY, l_reg, pa0, pa1, pa2, pa3); SBAR();        \
        if ((t) + 1 < NT) { SLOAD(KBASE((t) + 1), SB); SBAR(); }                                                                  \
        MASKT(PX0, PX1, (t)); SBAR();                                                                                          \
        pv_psm<(VB) * SHM_V, MODE == M_SEL>(o, V_lds + v_rd_base(lane), pa0, pa1, pa2, pa3, PX0, PX1, m_reg, mnX, alX, LANEON(t)); SBAR(); \
        __syncthreads();                                                                                                      \
        if ((t) + 1 < NT) { VMW(); SWRITE(SB); }                                                                              \
        RESC(alX); __syncthreads(); } while (0)
    for (int t = 1; t + 1 < NT; t += 2) {
        HALF_STEP(pB0, pB1, mnB, alB, pA0, pA1, alA, t, 1, 0, 0);
        HALF_STEP(pA0, pA1, mnA, alA, pB0, pB1, alB, t + 1, 0, 1, 1);
    }
    const bool even = (NT & 1) == 0;
    if (even) { SBAR(); qkt(pB0, pB1, K_lds + SHM_K, r32, hi, qr); SBAR(); }
    finishSM(pA0, pA1, alA, l_reg, pa0, pa1, pa2, pa3); SBAR();
    pv_tile<0>(o, vb0, pa0, pa1, pa2, pa3);
    if (even) { BIAS(pB0, pB1, 1); MASKT(pB0, pB1, NT - 1); partialSM<MODE == M_SEL>(pB0, pB1, m_reg, mnB, alB, LANEON(NT - 1)); __syncthreads(); RESC(alB);
        finishSM(pB0, pB1, alB, l_reg, pa0, pa1, pa2, pa3); SBAR(); pv_tile<SHM_V>(o, vb0, pa0, pa1, pa2, pa3); }
#undef HALF_STEP
#undef LANEON
#undef MASKT
#undef BIAS
#undef RESC
#undef SWRITE
#undef SLOAD
#undef VMW
#undef KBASE
#undef TILE
}
}

__device__ __forceinline__ void fox_unit(const Frame& F, int bh, int qb, float skip_margin, bool dummy = false) {
    using namespace att;
    const int wid = F.wave, P0 = qb * 256, qlo = P0 + wid * 32, b = bh >> 3, h = bh & 7;
    const bf16* Kh = ZP(Z_KF) + (size_t)bh * SEQ * HD; const bf16* Vh = ZP(Z_VF) + (size_t)bh * SEQ * HD; const float* cbh = (const float*)(F.ws + WS_Z + Z_CF) + (size_t)bh * SEQ;
    f32x16 o[4] = {}; float m_reg = -1e30f, l_reg = 0.f;
    bf16x8 qr[8], pk0, pk1, pv0, pv1;
#define FOX_IDS() const int lane = lane_id(), tid = wid * 64 + lane, r32 = lane & 31, hi = lane >> 5; (void)tid; (void)hi
#define FOX_LOADQ() { const bf16* Q = ZP(Z_QF) + ((size_t)bh * SEQ + qlo + r32) * HD; _Pragma("unroll") for (int d0 = 0; d0 < 8; ++d0) qr[d0] = *(const bf16x8*)(Q + d0 * 16 + hi * 8); }
    { FOX_IDS(); FOX_LOADQ();
      attn_stream<M_FOX>((LAS char*)F.lds, tid, wid, lane, qr, Kh, Vh, cbh, 4 * qb, 4, qlo + r32, qlo, qlo + 31, 0u, 0u, o, m_reg, l_reg);
      if (qb > 0) ATT_PRELOAD(Kh, Vh, (4 * qb - 1) * 64, tid, pk0, pk1, pv0, pv1); }
    if (qb > 0) {
        int j_lo;
        { FOX_IDS();
          float mm = fminf(m_reg, xlane<1>(m_reg)); mm = fminf(mm, xlane<2>(mm)); mm = fminf(mm, xlane<4>(mm)); mm = fminf(mm, xlane<8>(mm)); mm = fminf(mm, xlane<16>(mm));
          LAS float* mred = (LAS float*)(F.lds + 2 * SHM_V + 2 * SHM_K + 512);
          if (lane == 0) mred[wid * 64 + 48] = mm;
          __syncthreads();
          float T = mred[48];
#pragma unroll
          for (int w2 = 1; w2 < 8; ++w2) T = fminf(T, mred[w2 * 64 + 48]);
          T -= skip_margin;
          const bool sk = lane < 4 * qb && cbh[64 * lane + 63] < T;
          j_lo = __popcll(__ballot(sk)); }
        if (j_lo < 4 * qb) { FOX_IDS();
            attn_stream<M_FOX, true, true, true>((LAS char*)F.lds, tid, wid, lane, qr, Kh, Vh, cbh, j_lo, 4 * qb - j_lo, qlo + r32, qlo, qlo + 31, 0u, 0u, o, m_reg, l_reg, pk0, pk1, pv0, pv1); }
    }
    FOX_IDS();
    LAS float* li_l = (LAS float*)(F.lds + 2 * SHM_V + 2 * SHM_K + 512) + wid * 64 + 32;
    if (hi == 0) li_l[r32] = l_reg; LDS_WAIT();
    float rl[16];
#pragma unroll
    for (int r = 0; r < 16; ++r) rl[r] = __builtin_amdgcn_rcpf(li_l[crow(r, hi)]);
    __syncthreads();
    LAS float* img = (LAS float*)F.lds + wid * 4096;
#pragma unroll
    for (int r = 0; r < 16; ++r)
#pragma unroll
        for (int d0 = 0; d0 < 4; ++d0) img[crow(r, hi) * 128 + d0 * 32 + r32] = o[d0][r] * rl[r];
    LDS_WAIT();
    bf16* Y = ZP(Z_GC) + ((size_t)b * SEQ + qlo) * BW + h * HD; const long dofs = dummy ? (long)((bf16*)(F.ws + WS_X1) - ZP(Z_GC)) : 0;
    u32x4 gt[8];
#pragma unroll
    for (int it = 0; it < 8; ++it) { const int q = it * 64 + lane; gt[it] = *(const u32x4*)(Y + (size_t)(q >> 4) * BW + (q & 15) * 8); }
#pragma unroll
    for (int it = 0; it < 8; ++it) { const int q = it * 64 + lane; const f32x4 a = *(const LAS f32x4*)(img + (q >> 4) * 128 + (q & 15) * 8), c = *(const LAS f32x4*)(img + (q >> 4) * 128 + (q & 15) * 8 + 4);
        u32x4 y; y.x = cvt_pk_bf16(a.x * bf_lo(gt[it].x), a.y * bf_hi(gt[it].x)); y.y = cvt_pk_bf16(a.z * bf_lo(gt[it].y), a.w * bf_hi(gt[it].y));
        y.z = cvt_pk_bf16(c.x * bf_lo(gt[it].z), c.y * bf_hi(gt[it].z)); y.w = cvt_pk_bf16(c.z * bf_lo(gt[it].w), c.w * bf_hi(gt[it].w));
        *(u32x4*)(Y + dofs + (size_t)(q >> 4) * BW + (q & 15) * 8) = y; }
#undef FOX_IDS
#undef FOX_LOADQ
}

constexpr int NSA_OUT_OFF = 69632, NSA_IMP_OFF = RED_OFF;
#define NSA_IDS() const int lane = lane_id(), tid = wid * 64 + lane, r32 = lane & 31, hi = lane >> 5, tok = P0 + 8 * wid + (r32 >> 2), head = 4 * g + (r32 & 3); (void)tid; (void)hi; (void)tok; (void)head
#define NSA_PTRS() LAS float* fac = (LAS float*)(lds + MISC_OFF + 512) + wid * 64; LAS unsigned* oacc = (LAS unsigned*)(lds + NSA_OUT_OFF) + wid * 2048; \
        const float* BGp = (const float*)(F.ws + WS_Z + Z_BG) + ((size_t)b * SEQ + tok) * 24 + head * 3
#define NSA_LOADQ() { const bf16* Q = ZP(Z_QN) + ((size_t)(b * 8 + head) * SEQ + tok) * HD; _Pragma("unroll") for (int d0 = 0; d0 < 8; ++d0) qr[d0] = *(const bf16x8*)(Q + d0 * 16 + hi * 8); }
__device__ __forceinline__ void nsa_unit(const Frame& F, int bg, int blk, bool dummy = false) {
    using namespace att;
    const int wid = F.wave, P0 = blk * 64, b = bg >> 1, g = bg & 1, qlo = P0 + 8 * wid;
    LAS char* lds = (LAS char*)F.lds;
    constexpr float C2 = 1.4426950408889634f * SCALE;
    unsigned selLo, selHi;
    bf16x8 qr[8], pk0, pk1, pv0, pv1;
    const int jw_lo = blk >= 8 ? blk - 8 : 0;
    {
        NSA_IDS(); NSA_LOADQ();
        LAS float* impw = (LAS float*)(lds + NSA_IMP_OFF) + wid * 512;
        LAS unsigned* selm = (LAS unsigned*)(lds + MISC_OFF + 512) + wid * 64 + 32;
        const int nvm = P0 / 16 + 3, n_t = (nvm + 63) >> 6;
        const int nvis = tok >= 31 ? (tok - 31) / 16 + 1 : 0;
        LAS char* Kc = lds; LAS char* Vc = lds + 65536;
        __syncthreads();
        { const bf16* KC = (const bf16*)(F.ws + WS_KCMP) + (size_t)bg * 256 * HD; const bf16* VC = (const bf16*)(F.ws + WS_VCMP) + (size_t)bg * 256 * HD;
          const int sr = tid >> 4, sc = (tid & 15) * 8, vst0 = v_st(sr, sc), vst1 = v_st(32 + sr, sc), kws = KSWZ(sr, sc * 2);
          for (int ti = 0; ti < n_t; ti += 2) {
              const bool two = ti + 1 < n_t;
              const bf16x8 k0 = *(const bf16x8*)(KC + (size_t)(64 * ti + sr) * HD + sc), k1 = *(const bf16x8*)(KC + (size_t)(64 * ti + 32 + sr) * HD + sc);
              const bf16x8 v0 = *(const bf16x8*)(VC + (size_t)(64 * ti + sr) * HD + sc), v1 = *(const bf16x8*)(VC + (size_t)(64 * ti + 32 + sr) * HD + sc);
              bf16x8 k2 = k0, k3 = k1, v2 = v0, v3 = v1;
              if (two) { k2 = *(const bf16x8*)(KC + (size_t)(64 * ti + 64 + sr) * HD + sc); k3 = *(const bf16x8*)(KC + (size_t)(64 * ti + 96 + sr) * HD + sc);
                         v2 = *(const bf16x8*)(VC + (size_t)(64 * ti + 64 + sr) * HD + sc); v3 = *(const bf16x8*)(VC + (size_t)(64 * ti + 96 + sr) * HD + sc); }
              *(LAS bf16x8*)(Kc + ti * SHM_K + kws) = k0; *(LAS bf16x8*)(Kc + ti * SHM_K + kws + 32 * 256) = k1;
              *(LAS bf16x8*)(Vc + ti * SHM_V + vst0) = v0; *(LAS bf16x8*)(Vc + ti * SHM_V + vst1) = v1;
              if (two) { *(LAS bf16x8*)(Kc + (ti + 1) * SHM_K + kws) = k2; *(LAS bf16x8*)(Kc + (ti + 1) * SHM_K + kws + 32 * 256) = k3;
                         *(LAS bf16x8*)(Vc + (ti + 1) * SHM_V + vst0) = v2; *(LAS bf16x8*)(Vc + (ti + 1) * SHM_V + vst1) = v3; } } }
        for (int x = lane; x < 512; x += 64) impw[x] = 0.f;
        __syncthreads();
        float m = -1e30f, l = 0.f;
#pragma unroll
        for (int ti = 0; ti < 4; ++ti) if (ti < n_t) {
            f32x16 p0, p1; qkt(p0, p1, Kc + ti * SHM_K, r32, hi, qr);
            mask_tile(p0, p1, nvis - 1 - 64 * ti - 4 * hi, 0x80000000u);
            float pmax = p0[0];
#pragma unroll
            for (int r = 1; r < 16; ++r) pmax = fmaxf(pmax, p0[r]);
#pragma unroll
            for (int r = 0; r < 16; ++r) pmax = fmaxf(pmax, p1[r]);
            { auto rr = __builtin_amdgcn_permlane32_swap(__float_as_uint(pmax), __float_as_uint(pmax), false, false); pmax = fmaxf(__uint_as_float(rr[0]), __uint_as_float(rr[1])); }
            const float mn = fmaxf(m, pmax), mnL = -mn * C2; float ps = 0.f;
#pragma unroll
            for (int r = 0; r < 16; ++r) ps += __builtin_amdgcn_exp2f(fmaf(p0[r], C2, mnL)) + __builtin_amdgcn_exp2f(fmaf(p1[r], C2, mnL));
            ps = xsum32(ps);
            l = l * __builtin_amdgcn_exp2f((m - mn) * C2) + ps; m = mn;
        }
        const float rl = l > 0.f ? 1.0f / l : 0.f, mL = -m * C2;
        f32x16 o[4] = {};
        const int vbc = (int)(unsigned)(uintptr_t)Vc + v_rd_base(lane);
        LAS float* impt = impw + (r32 >> 2) * 64;
#define NSA_CMP_TILE(ti) do { if ((ti) < n_t) { \
            f32x16 p0, p1; qkt(p0, p1, Kc + (ti) * SHM_K, r32, hi, qr); \
            mask_tile(p0, p1, nvis - 1 - 64 * (ti) - 4 * hi, 0x80000000u); \
            _Pragma("unroll") for (int r = 0; r < 16; ++r) { p0[r] = __builtin_amdgcn_exp2f(fmaf(p0[r], C2, mL)) * rl; p1[r] = __builtin_amdgcn_exp2f(fmaf(p1[r], C2, mL)) * rl; } \
            _Pragma("unroll") for (int g4 = 0; g4 < 4; ++g4) { \
                float q0 = (p0[4 * g4] + p0[4 * g4 + 1]) + (p0[4 * g4 + 2] + p0[4 * g4 + 3]), e0 = p0[4 * g4 + 3], q1 = (p1[4 * g4] + p1[4 * g4 + 1]) + (p1[4 * g4 + 2] + p1[4 * g4 + 3]), e1 = p1[4 * g4 + 3]; \
                q0 += xlane<1>(q0); q0 += xlane<2>(q0); e0 += xlane<1>(e0); e0 += xlane<2>(e0); q1 += xlane<1>(q1); q1 += xlane<2>(q1); e1 += xlane<1>(e1); e1 += xlane<2>(e1);     \
                if ((r32 & 3) == 0) { const int j0 = 16 * (ti) + 2 * g4 + hi, j1 = j0 + 8; \
                    __hip_atomic_fetch_add(impt + j0, q0, __ATOMIC_RELAXED, __HIP_MEMORY_SCOPE_WORKGROUP); __hip_atomic_fetch_add(impt + j0 + 1, e0, __ATOMIC_RELAXED, __HIP_MEMORY_SCOPE_WORKGROUP); \
                    __hip_atomic_fetch_add(impt + j1, q1, __ATOMIC_RELAXED, __HIP_MEMORY_SCOPE_WORKGROUP); if (j1 < 63) __hip_atomic_fetch_add(impt + j1 + 1, e1, __ATOMIC_RELAXED, __HIP_MEMORY_SCOPE_WORKGROUP); } } \
            bf16x8 pa0, pa1, pa2, pa3; PK4(p0, 0, pa0); PK4(p0, 8, pa1); PK4(p1, 0, pa2); PK4(p1, 8, pa3); \
            pv_tile<(ti) * SHM_V>(o, vbc, pa0, pa1, pa2, pa3); } } while (0)
        NSA_CMP_TILE(0); NSA_CMP_TILE(1); NSA_CMP_TILE(2); NSA_CMP_TILE(3);
#undef NSA_CMP_TILE
        ATT_PRELOAD(ZP(Z_KS) + (size_t)bg * SEQ * HD, ZP(Z_VS) + (size_t)bg * SEQ * HD, 0, tid, pk0, pk1, pv0, pv1);
        LDS_WAIT();
        const float INF = __builtin_inff();
        for (int tl = 0; tl < 8; ++tl) {
            const bool fj = (lane == 0) || (lane == blk) || (lane == blk - 1);
            const float sj = fj ? INF : (lane <= blk ? impw[tl * 64 + lane] : -INF);
            int rank = 0;
#pragma unroll
            for (int x = 0; x < 64; ++x) { const float sx = __uint_as_float((unsigned)__builtin_amdgcn_readlane((int)__float_as_uint(sj), x)); rank += (sx > sj || (sx == sj && x < lane)) ? 1 : 0; }
            const unsigned long long bal = __ballot(rank < 16);
            if (lane == 0) { selm[tl * 2] = (unsigned)bal; selm[tl * 2 + 1] = (unsigned)(bal >> 32); }
        }
        LDS_WAIT();
        selLo = selm[(r32 >> 2) * 2]; selHi = selm[(r32 >> 2) * 2 + 1];
        NSA_PTRS();
        if (hi == 0) fac[r32] = BGp[0];
        __syncthreads();
#pragma unroll
        for (int r = 0; r < 16; r += 2) { const float f0 = fac[crow(r, hi)], f1 = fac[crow(r, hi) + 1];
#pragma unroll
            for (int d0 = 0; d0 < 4; ++d0) oacc[(d0 * 8 + (r >> 1)) * 64 + lane] = cvt_pk_bf16(o[d0][r] * f0, o[d0][r + 1] * f1); }
    }
    {
        f32x16 o[4] = {}; float m_reg = -1e30f, l_reg = 0.f;
        { NSA_IDS();
          attn_stream<M_SEL, false, true>(lds, tid, wid, lane, qr, ZP(Z_KS) + (size_t)bg * SEQ * HD, ZP(Z_VS) + (size_t)bg * SEQ * HD, nullptr, 0, blk + 1, tok, qlo, qlo + 7, selLo, selHi, o, m_reg, l_reg, pk0, pk1, pv0, pv1);
          ATT_PRELOAD(ZP(Z_KW) + (size_t)bg * SEQ * HD, ZP(Z_VW) + (size_t)bg * SEQ * HD, jw_lo * 64, tid, pk0, pk1, pv0, pv1); }
        NSA_IDS(); NSA_PTRS();
        if (hi == 0) fac[r32] = BGp[1] * __builtin_amdgcn_rcpf(l_reg);
        LDS_WAIT();
#pragma unroll
        for (int r = 0; r < 16; r += 2) { const float f0 = fac[crow(r, hi)], f1 = fac[crow(r, hi) + 1];
#pragma unroll
            for (int d0 = 0; d0 < 4; ++d0) { const unsigned w = oacc[(d0 * 8 + (r >> 1)) * 64 + lane];
                oacc[(d0 * 8 + (r >> 1)) * 64 + lane] = cvt_pk_bf16(bf_lo(w) + o[d0][r] * f0, bf_hi(w) + o[d0][r + 1] * f1); } }
    }
    {
        f32x16 o[4] = {}; float m_reg = -1e30f, l_reg = 0.f;
        { NSA_IDS();
          attn_stream<M_WIN, false, true>(lds, tid, wid, lane, qr, ZP(Z_KW) + (size_t)bg * SEQ * HD, ZP(Z_VW) + (size_t)bg * SEQ * HD, nullptr, jw_lo, blk - jw_lo + 1, tok, qlo, qlo + 7, 0u, 0u, o, m_reg, l_reg, pk0, pk1, pv0, pv1); }
        NSA_IDS(); NSA_PTRS();
        if (hi == 0) fac[r32] = BGp[2] * __builtin_amdgcn_rcpf(l_reg);
        LDS_WAIT();
#pragma unroll
        for (int r = 0; r < 16; r += 2) { const float f0 = fac[crow(r, hi)], f1 = fac[crow(r, hi) + 1];
#pragma unroll
            for (int d0 = 0; d0 < 4; ++d0) { const unsigned w = oacc[(d0 * 8 + (r >> 1)) * 64 + lane]; o[d0][r] = bf_lo(w) + o[d0][r] * f0; o[d0][r + 1] = bf_hi(w) + o[d0][r + 1] * f1; } }
        LAS bf16* img = (LAS bf16*)oacc;
#pragma unroll
        for (int r = 0; r < 16; ++r)
#pragma unroll
            for (int d0 = 0; d0 < 4; ++d0) img[crow(r, hi) * 128 + d0 * 32 + r32] = (bf16)f2bf(o[d0][r]);
        LDS_WAIT();
        bf16* Y = ZP(Z_GB) + ((size_t)b * SEQ + qlo) * BW + (4 * g) * HD; const long dofs = dummy ? (long)((bf16*)(F.ws + WS_X1) - ZP(Z_GB)) : 0;
        u32x4 gt[8];
#pragma unroll
        for (int it = 0; it < 8; ++it) { const int q = it * 64 + lane, row = q >> 4; gt[it] = *(const u32x4*)(Y + (size_t)(row >> 2) * BW + (row & 3) * HD + (q & 15) * 8); }
#pragma unroll
        for (int it = 0; it < 8; ++it) { const int q = it * 64 + lane, row = q >> 4; const u32x4 a = *(const LAS u32x4*)(img + row * 128 + (q & 15) * 8);
            u32x4 y; y.x = cvt_pk_bf16(bf_lo(a.x) * bf_lo(gt[it].x), bf_hi(a.x) * bf_hi(gt[it].x)); y.y = cvt_pk_bf16(bf_lo(a.y) * bf_lo(gt[it].y), bf_hi(a.y) * bf_hi(gt[it].y));
            y.z = cvt_pk_bf16(bf_lo(a.z) * bf_lo(gt[it].z), bf_hi(a.z) * bf_hi(gt[it].z)); y.w = cvt_pk_bf16(bf_lo(a.w) * bf_lo(gt[it].w), bf_hi(a.w) * bf_hi(gt[it].w));
            *(u32x4*)(Y + dofs + (size_t)(row >> 2) * BW + (row & 3) * HD + (q & 15) * 8) = y; }
    }
}
#undef NSA_IDS
#undef NSA_PTRS
#undef NSA_LOADQ

constexpr int N_PHASES = 1 + DEPTH * 8;

__device__ __forceinline__ void inproj_tail(const Frame& F, int l, const LayerW& W) {
    const int lane = lane_id(), fr = lane & 15, kq = lane >> 4;
    const int rows_per_wg = T / F.G, nsub = rows_per_wg / 16;
    const float* PS = (const float*)(F.ws + WS_PS); float* BG = (float*)(F.ws + WS_Z + Z_BG); float* LF = (float*)(F.ws + WS_Z + Z_LF);
    const bf16* Bt = W.Win + (size_t)(NIN - 32) * DM;
    constexpr int TP = 4112;
    __syncthreads();
    { const int tid = F.wave * 64 + lane;
#pragma unroll
      for (int jb = 0; jb < 16; jb += 8) { u32x4 w[8];
#pragma unroll
          for (int j = 0; j < 8; ++j) { const int e = tid + 512 * (jb + j); w[j] = *(const u32x4*)(Bt + (size_t)(e >> 8) * DM + (e & 255) * 8); }
#pragma unroll
          for (int j = 0; j < 8; ++j) { const int e = tid + 512 * (jb + j); *(LAS u32x4*)(F.lds + (e >> 8) * TP + (e & 255) * 16) = w[j]; } } }
    __syncthreads();
    for (int sub = F.wave; sub < nsub; sub += NWAVES) {
        const size_t row0 = (size_t)F.vcu * rows_per_wg + sub * 16;
        const bf16* ap = (const bf16*)(F.ws + WS_X2) + (row0 + fr) * DM + kq * 8;
        const LAS unsigned char* b0 = F.lds + fr * TP + kq * 16; const LAS unsigned char* b1 = b0 + 16 * TP;
        f32x4 c0 = {0.f, 0.f, 0.f, 0.f}, c1 = c0;
#pragma unroll 16
        for (int ks = 0; ks < DM / 32; ++ks) { const bf16x8 a = *(const bf16x8*)(ap + ks * 32), x0 = *(const LAS bf16x8*)(b0 + ks * 64), x1 = *(const LAS bf16x8*)(b1 + ks * 64);
            c0 = __builtin_amdgcn_mfma_f32_16x16x32_bf16(a, x0, c0, 0, 0, 0); c1 = __builtin_amdgcn_mfma_f32_16x16x32_bf16(a, x1, c1, 0, 0, 0); }
        const float bz0 = W.bias[NIN - 32 + fr], bz1 = W.bias[NIN - 16 + fr];
#pragma unroll
        for (int i = 0; i < 4; ++i) { const size_t row = row0 + 4 * kq + i; const float* pp = PS + row * 8; const f32x4 q0 = *(const f32x4*)pp, q1 = *(const f32x4*)(pp + 4);
            const float rs = 1.0f / sqrtf((((q0.x + q0.y) + (q0.z + q0.w)) + ((q1.x + q1.y) + (q1.z + q1.w))) * (1.f / DM) + EPS);
            const float v0 = c0[i] * rs + bz0, v1 = c1[i] * rs + bz1;
            BG[row * 24 + fr] = sigmoidf_(v0);
            if (fr < 8) BG[row * 24 + 16 + fr] = sigmoidf_(v1);
            else LF[row * 8 + (fr - 8)] = (v1 >= 0.f) ? -log1pf(__expf(-v1)) : (v1 - log1pf(__expf(v1))); }
    }
}
__device__ __forceinline__ void phase_inproj(const Frame& F0, int l, bool plain = false) {
    const Frame F = pin(F0); const LayerW W = layer_w(F.ws, l); const bf16* XA = (const bf16*)(F.ws + WS_X2);
    { PHASE_IDS(); const int gt = F.vcu * NTHREADS + tid;
      if (gt < 512) { const int j = gt >> 8, n = gt & 255; float sv = 0.f; for (int c = 0; c < 16; ++c) sv += W.posp[(j * 16 + c) * 256 + n]; W.posb[gt] = sv; } }
    if (l == 0) { inproj_tail(F, l, W); __syncthreads(); }
    int cur_pm = -1;
    { const bf16* A8 = (const bf16*)(F.ws + WS_A8);
      pg8::Gemm g{A8, A8, A8, W.Win, W.Win, W.Win}; pg8::StaticOrder<T, NIN - 32> S; S.init(F.G, (int)blockIdx.x);
      EpiIn E{F.ws, W.bias, INP(I_NQG) + (size_t)l * HD, INP(I_NKG) + (size_t)l * HD, INP(I_FQG) + (size_t)l * HD, INP(I_FKG) + (size_t)l * HD, (LAS float*)(F.lds + RED_OFF), (const float*)(F.ws + WS_PS), &cur_pm, plain, 0, 1.0f,
              (const float*)(F.ws + WS_RSE), W.sw, true};
      pg8::gemm_phase<DM / 2, DM, DM / 2, 1, 2>(F.lds, g, S, E, F.wave); }
}
__device__ __forceinline__ void phase_tail(const Frame& F0, int l) { const Frame F = pin(F0); const LayerW W = layer_w(F.ws, l); inproj_tail(F, l, W); }
__device__ __forceinline__ void phase_p3(const Frame& F0, int l) {
    const Frame F = pin(F0); const LayerW W = layer_w(F.ws, l);
    constexpr int nc = 32;
    if ((int)blockIdx.x < nc) {
        pg8::Gemm g{ZP(Z_KC), ZP(Z_VC), ZP(Z_VC), W.Wc1, W.Wc1 + (size_t)CMPH * 4096, W.Wc1}; pg8::OneEach S{16, 32, (int)blockIdx.x};
        EpiCmp E{W.posb, W.w2t, INP(I_NKG) + (size_t)l * HD, (bf16*)(F.ws + WS_KCMP), (bf16*)(F.ws + WS_VCMP)};
        pg8::gemm_phase<2048, 4096, 4096, 2>(F.lds, g, S, E, F.wave);
    } else {
        PHASE_IDS();
        const int nb = F.G - nc, me = (int)blockIdx.x - nc;
        for (int u = me; u < LRU_UNITS; u += nb) lru_unit<1>(F, tid, lane, l, u, W.gw);
        for (int it = me * NWAVES + F.wave; it < 64; it += nb * NWAVES) fox_cumsum_item(F, lane, it);
    }
}
__device__ __forceinline__ void phase_mixers(const Frame& F0, int l) {
    const Frame F = pin(F0);
    for (int rep = (REPMASK & 512) ? 0 : 1; rep < 2; ++rep) {
#pragma unroll 1
        for (int k = 0; k < 4; ++k) { const int it = (int)blockIdx.x + 256 * ((k + 2) & 3); const int pr = it % 512, bg = pr >> 5, x = pr & 31; nsa_unit(F, bg, it < 512 ? x : 63 - x, rep == 0); }
        __syncthreads(); }
    float skip_margin;
    { const int lane = lane_id(); const float* gq = INP(I_FQG) + (size_t)l * HD; const float* gk = INP(I_FKG) + (size_t)l * HD;
      float a = fmaxf(fabsf(gq[lane]), fabsf(gq[lane + 64])), c = fmaxf(fabsf(gk[lane]), fabsf(gk[lane + 64]));
      a = fmaxf(a, xlane<1>(a)); a = fmaxf(a, xlane<2>(a)); a = fmaxf(a, xlane<4>(a)); a = fmaxf(a, xlane<8>(a)); a = fmaxf(a, xlane<16>(a));
      c = fmaxf(c, xlane<1>(c)); c = fmaxf(c, xlane<2>(c)); c = fmaxf(c, xlane<4>(c)); c = fmaxf(c, xlane<8>(c)); c = fmaxf(c, xlane<16>(c));
      { auto rr = __builtin_amdgcn_permlane32_swap(__float_as_uint(a), __float_as_uint(a), false, false); a = fmaxf(__uint_as_float(rr[0]), __uint_as_float(rr[1])); }
      { auto rr = __builtin_amdgcn_permlane32_swap(__float_as_uint(c), __float_as_uint(c), false, false); c = fmaxf(__uint_as_float(rr[0]), __uint_as_float(rr[1])); }
      const float qkB = 1.02f * 11.313708499f * a * c;
      skip_margin = __uint_as_float((unsigned)__builtin_amdgcn_readfirstlane((int)__float_as_uint((qkB + 22.0f) * (1.0f / SCALE)))); }
    for (int rep = (REPMASK & 128) ? 0 : 1; rep < 2; ++rep) {
#pragma unroll 1
        for (int k = 0; k < 4; ++k) { const int it = (int)blockIdx.x + 256 * ((k + 2) & 3); const int pr = it % 512, bh = pr >> 3, x = pr & 7; fox_unit(F, bh, it < 512 ? x : 15 - x, skip_margin, rep == 0); }
        __syncthreads(); }
    for (int rep = (REPMASK & 16) ? 0 : 1; rep < 2; ++rep) {
        const int lane = lane_id(), tid = F.wave * 64 + lane;
        for (int u = (int)blockIdx.x; u < LRU_UNITS; u += F.G) lru_unit<2>(F, tid, lane, l, u, layer_w(F.ws, l).gw, rep == 0);
        __syncthreads(); }
}
__device__ __forceinline__ void phase_branch(const Frame& F0, int l) {
    const Frame F = pin(F0); const LayerW W = layer_w(F.ws, l);
    pg8::Gemm g{ZP(Z_GA), ZP(Z_GB), ZP(Z_GC), W.Wbr, W.Wbr + (size_t)DM * BW, W.Wbr + (size_t)2 * DM * BW}; pg8::StaticOrder<T, DM, 3> S; S.init(F.G, (int)blockIdx.x);
    EpiBranch E{(const unsigned char*)ZP(Z_MG), ZP(Z_QF)}; pg8::gemm_phase<BW, BW, BW, 3>(F.lds, g, S, E, F.wave);
}
__device__ __forceinline__ void phase_eraw(const Frame& F0, int l) {
    const Frame F = pin(F0); const LayerW W = layer_w(F.ws, l);
    const bf16* pbf = (const bf16*)(F.ws + WS_PB) + (size_t)l * T * PLE; bf16* X1 = (bf16*)(F.ws + WS_X1);
    pg8::Gemm g{pbf, pbf, pbf, W.Wple, W.Wple, W.Wple}; pg8::StaticOrder<T, DM> S; S.init(F.G, (int)blockIdx.x);
    EpiEraw E{X1, (float*)(F.ws + WS_PSE), (LAS float*)(F.lds + RED_OFF)}; pg8::gemm_phase<PLE, PLE, PLE, 1>(F.lds, g, S, E, F.wave);
}
__device__ __forceinline__ void phase_outproj(const Frame& F0, int l, bool dummy = false) {
    const Frame F = pin(F0); const LayerW W = layer_w(F.ws, l);
    const bf16* MR = I8_P6 ? ZP(Z_GA) : ZP(Z_QF);
    pg8::Gemm g{MR, MR, MR, W.Wout, W.Wout, W.Wout}; pg8::StaticOrder<T, DM> S; S.init(F.G, (int)blockIdx.x);
    EpiOut E{(l == 0) ? INP(I_X) : nullptr, (const bf16*)(F.ws + WS_X2), dummy ? ZP(Z_MG) : (bf16*)(F.ws + WS_X0), (const float*)(F.ws + WS_HID + MiB), W.so};
    if (I8_P6) pg8::gemm_phase<DM / 2, DM, DM / 2, 1, 2>(F.lds, g, S, E, F.wave); else pg8::gemm_phase<DM, DM, DM, 1>(F.lds, g, S, E, F.wave);
}
__device__ __forceinline__ void phase_gate(const Frame& F0, int l, bool dummy = false) {
    const Frame F = pin(F0); const LayerW W = layer_w(F.ws, l);
    const bf16* X0 = (const bf16*)(F.ws + WS_X0); const bf16* AO = I8_P7 ? ZP(Z_U) : X0;
    pg8::Gemm g{AO, AO, AO, W.Wgate, W.Wgate, W.Wgate}; pg8::StaticOrder<T, DM> S; S.init(F.G, (int)blockIdx.x);
    EpiGate E{X0, dummy ? (float*)(F.ws + WS_Z + Z_MG) : (l == DEPTH - 1 ? F.out : nullptr), (const bf16*)(F.ws + WS_X1), (const float*)(F.ws + WS_PSE), INP(I_PLEG) + (size_t)l * DM,
              dummy ? ZP(Z_MG) + (size_t)128 * MiB : (l == DEPTH - 1 ? nullptr : (bf16*)(F.ws + WS_X2)),        dummy ? (float*)(F.ws + WS_Z + Z_LF) : (float*)(F.ws + WS_PS), (LAS float*)(F.lds + RED_OFF), (const float*)(F.ws + WS_HID), W.sg};
    if (I8_P7) pg8::gemm_phase<DM / 2, DM, DM / 2, 1, 2>(F.lds, g, S, E, F.wave); else pg8::gemm_phase<DM, DM, DM, 1>(F.lds, g, S, E, F.wave);
}

__global__ void __launch_bounds__(NTHREADS, 2) fwd_kernel(Args args) {
    extern __shared__ __attribute__((aligned(16))) unsigned char lds_raw[];
    Frame F;
    F.lds = (LAS unsigned char*)lds_raw;
    F.wave = __builtin_amdgcn_readfirstlane((int)threadIdx.x >> 6);
    F.G = gridDim.x; { const int bx = blockIdx.x; F.vcu = (F.G % 8 == 0) ? (bx % 8) * (F.G / 8) + bx / 8 : bx; }
    F.A = (const CAS ArgsG*)__builtin_amdgcn_kernarg_segment_ptr(); F.out_g = F.A->out; F.ws_g = F.A->ws; F.out = (float*)F.out_g; F.ws = (unsigned char*)F.ws_g;
    volatile LAS unsigned* MISC = (volatile LAS unsigned*)(F.lds + MISC_OFF);
    { const int l0 = lane_id(); if (F.wave == 0 && l0 < 32) MISC[l0] = 0u; }
    __syncthreads();
    XcdBarrier bar; bar.bar = (unsigned*)(F.ws + WS_CTL) + CW_BAR; bar.x = 0; bar.st = nullptr;
    if (!MK_PER_PHASE) bar = xcd_barrier_post((unsigned*)(F.ws + WS_CTL) + CW_BAR, MISC + 8, F.wave == 0 && lane_id() == 0);
    const int lo = F.A->ph_lo, hi = F.A->ph_hi;
#define IN(k) (lo <= (k) && (k) < hi)
#define SEAM(k) do { if (IN((k) + 1)) { if (MK_PER_PHASE) { } else xcd_barrier(bar, F.wave == 0 && lane_id() == 0); } } while (0)

    if (IN(0)) { phase_prologue(F); if (!P0_FUSEQ) { xcd_barrier(bar, F.wave == 0 && lane_id() == 0); phase_quant_w(F); } SEAM(0); }

    for (int l = 0; l < DEPTH; ++l) {
        const int pb = 1 + l * 8;
        if (IN(pb + 0) && l > 0) { phase_quant_a(F); phase_tail(F, l); SEAM(pb + 0); }
        if (IN(pb + 1) && !(SKIPMASK & 2)) { if (REPMASK & 4096) phase_inproj(F, l, true); phase_inproj(F, l); if (REPMASK & 2) phase_inproj(F, l); SEAM(pb + 1); }
        if (IN(pb + 2) && !(SKIPMASK & 4)) { phase_p3(F, l); if (REPMASK & 4) phase_p3(F, l); SEAM(pb + 2); }
        if (IN(pb + 4) && !(SKIPMASK & 16)) { phase_mixers(F, l); SEAM(pb + 4); }
        if (IN(pb + 5) && !(SKIPMASK & 32)) { phase_branch(F, l); if (REPMASK & 32) phase_branch(F, l); phase_eraw(F, l); if (REPMASK & 64) phase_eraw(F, l); SEAM(pb + 5);
            if (I8_P6) { phase_quant_a(F, WS_Z + Z_QF, WS_Z + Z_GA, WS_HID + MiB); xcd_barrier(bar, F.wave == 0 && lane_id() == 0); } }
        if (IN(pb + 6) && !(SKIPMASK & 64)) { if (REPMASK & 1024) phase_outproj(F, l, true); phase_outproj(F, l); SEAM(pb + 6);
            if (I8_P7) { phase_quant_a(F, WS_X0, WS_Z + Z_U, WS_HID); xcd_barrier(bar, F.wave == 0 && lane_id() == 0); } }
        if (IN(pb + 7) && !(SKIPMASK & 128)) { if (REPMASK & 2048) phase_gate(F, l, true); phase_gate(F, l); SEAM(pb + 7); }
    }
#undef IN
#undef SEAM
}

extern "C" void kernel_launch(void* const* d_in, const int* in_sizes, int n_in, void* d_out, int out_size, void* d_ws, size_t ws_size, hipStream_t stream) {
    static int grid = 0;
    if (grid == 0) {
        if (n_in != 24 || in_sizes[0] != T * DM || out_size != T * DM || ws_size < WS_END) {
            fprintf(stderr, "kernel_launch: unexpected shapes (n_in %d, in0 %d, out %d, ws %zu < %zu); nothing launched\n", n_in, n_in > 0 ? in_sizes[0] : -1, out_size, ws_size, (size_t)WS_END); grid = -1; return; }
        int dev = 0, cus = 0, per_cu = 0;
        if (hipGetDevice(&dev) != hipSuccess || hipDeviceGetAttribute(&cus, hipDeviceAttributeMultiprocessorCount, dev) != hipSuccess) { grid = -1; return; }
        if (hipFuncSetAttribute((const void*)fwd_kernel, hipFuncAttributeMaxDynamicSharedMemorySize, LDS_BYTES) != hipSuccess) { fprintf(stderr, "kernel_launch: hipFuncSetAttribute failed\n"); grid = -1; return; }
        if (hipOccupancyMaxActiveBlocksPerMultiprocessor(&per_cu, (const void*)fwd_kernel, NTHREADS, LDS_BYTES) != hipSuccess || per_cu < 1) {
            fprintf(stderr, "kernel_launch: occupancy query reports %d workgroups per CU; nothing launched\n", per_cu); (void)hipGetLastError(); grid = -1; return; }
        if (cus < 256) { fprintf(stderr, "kernel_launch: this kernel is laid out for the 256 CUs of an MI355X (found %d); nothing launched\n", cus); grid = -1; return; }
        grid = 256;
    }
    if (grid < 0) return;
    (void)hipMemsetAsync((char*)d_ws + WS_CTL, 0, CTL_ZERO_BYTES, stream);
    Args a{};
    for (int i = 0; i < 24; ++i) a.in[i] = (const float*)d_in[i];
    a.out = (float*)d_out; a.ws = (unsigned char*)d_ws;
#if MK_PER_PHASE
    for (int p = 0; p < N_PHASES; ++p) { a.ph_lo = p; a.ph_hi = p + 1; hipLaunchKernelGGL(fwd_kernel, dim3(grid), dim3(NTHREADS), LDS_BYTES, stream, a); }
#else
    a.ph_lo = 0; a.ph_hi = N_PHASES;
    hipLaunchKernelGGL(fwd_kernel, dim3(grid), dim3(NTHREADS), LDS_BYTES, stream, a);
#endif
    const hipError_t le = hipPeekAtLastError();
    if (le != hipSuccess) fprintf(stderr, "kernel_launch: launch failed: %s\n", hipGetErrorName(le));
}
```
